# Optimizing an MI355X kernel written in HIP

```python
import math
import jax, jax.numpy as jnp
from jax import lax
import numpy as np

D_MODEL = 2048
BATCH = 1
SEQ = 16384
DEPTH = 2

N_MEM = 256
MIX_W = D_MODEL // 2
GLA_HEADS = 4
GLA_DV = MIX_W // GLA_HEADS
GLA_DK = GLA_DV // 2
GLA_RANK = 16
GLA_TAU = 16.0
GLA_CHUNK = 64
SB_HEADS = 8
SB_DH = MIX_W // SB_HEADS
SB_BLOCK = 128
MEM_HEADS = 4
MEM_DH = MIX_W // MEM_HEADS
N_BRANCH = 3
D_FF = int(math.ceil(8 * D_MODEL / 3 / 256) * 256)
EPS = 1e-6

SPLIT_SIZES = [
    GLA_HEADS * GLA_DK,
    GLA_HEADS * GLA_DK,
    GLA_HEADS * GLA_DV,
    GLA_HEADS * GLA_DV,
    GLA_RANK,
    SB_HEADS * SB_DH,
    SB_HEADS * SB_DH,
    SB_HEADS * SB_DH,
    MEM_HEADS * MEM_DH,
    N_BRANCH * D_MODEL,
]
IN_W = int(sum(SPLIT_SIZES))
SPLIT_POINTS = [int(p) for p in np.cumsum(SPLIT_SIZES)[:-1]]

kernel_name = "hybrid_gla_stickbreaking_memxattn_gated"


def rmsnorm(x, g):
    xf = x.astype(jnp.float32)
    y = xf * lax.rsqrt(jnp.mean(xf * xf, axis=-1, keepdims=True) + EPS)
    return (y * g.astype(jnp.float32)).astype(x.dtype)


def gla_mixer(q, k, v, log_a):
    B, T, H, dk = q.shape
    dv = v.shape[-1]
    N = T // GLA_CHUNK

    def chunk(a):
        return a.astype(jnp.float32).reshape(B, N, GLA_CHUNK, H, a.shape[-1]).transpose(0, 3, 1, 2, 4)

    qc = chunk(q) * (dk ** -0.5)
    kc, vc, gc = chunk(k), chunk(v), chunk(log_a)
    b = jnp.cumsum(gc, axis=3)
    b_last = b[:, :, :, -1:, :]
    q_e = qc * jnp.exp(b)
    k_e = kc * jnp.exp(-b)
    k_d = kc * jnp.exp(b_last - b)
    decay = jnp.exp(b_last[:, :, :, 0, :])

    causal = jnp.tril(jnp.ones((GLA_CHUNK, GLA_CHUNK), dtype=bool))
    s = jnp.where(causal, jnp.einsum('bhncd,bhnsd->bhncs', q_e, k_e), 0.0)
    o_intra = jnp.einsum('bhncs,bhnsv->bhncv', s, vc)

    def step(S, inp):
        qe, kd, vv, dec = inp
        o = jnp.einsum('bhcd,bhdv->bhcv', qe, S)
        S = S * dec[..., :, None] + jnp.einsum('bhcd,bhcv->bhdv', kd, vv)
        return S, o

    xs = (jnp.moveaxis(q_e, 2, 0), jnp.moveaxis(k_d, 2, 0), jnp.moveaxis(vc, 2, 0), jnp.moveaxis(decay, 2, 0))
    S0 = jnp.zeros((B, H, dk, dv), jnp.float32)
    _, o_inter = lax.scan(step, S0, xs)
    o = o_intra + jnp.moveaxis(o_inter, 0, 2)
    return o.transpose(0, 2, 3, 1, 4).reshape(B, T, H, dv)


def stick_breaking_mixer(q, k, v):
    B, T, H, d = q.shape
    NB = T // SB_BLOCK
    scale = d ** -0.5
    qt = q.transpose(0, 2, 1, 3)
    kt = k.transpose(0, 2, 1, 3)
    vt = v.transpose(0, 2, 1, 3)
    idx = jnp.arange(SB_BLOCK)
    later = (idx[:, None] > idx[None, :]).astype(jnp.float32)
    outs = []
    for i in range(NB):
        L = (i + 1) * SB_BLOCK
        qi = qt[:, :, i * SB_BLOCK:L]
        kb = kt[:, :, :L]
        vb = vt[:, :, :L]
        z = jnp.einsum('bhqd,bhkd->bhqk', qi, kb).astype(jnp.float32) * scale
        mask = jnp.arange(L)[None, :] < (i * SB_BLOCK + idx)[:, None]
        l = jnp.where(mask, jax.nn.log_sigmoid(-z), 0.0).reshape(B, H, SB_BLOCK, i + 1, SB_BLOCK)
        within = jnp.einsum('bhqnj,js->bhqns', l, later)
        tot = jnp.sum(l, axis=-1)
        after = lax.cumsum(tot, axis=3, reverse=True) - tot
        rest = (within + after[..., None]).reshape(B, H, SB_BLOCK, L)
        A = jnp.where(mask, jnp.exp(jax.nn.log_sigmoid(z) + rest), 0.0)
        outs.append(jnp.einsum('bhqk,bhkd->bhqd', A.astype(vb.dtype), vb))
    out = jnp.concatenate(outs, axis=2)
    return out.transpose(0, 2, 1, 3).reshape(B, T, H * d)


def memory_mixer(q, mem_k, mem_v):
    B, T, H, d = q.shape
    s = jnp.einsum('bthd,bmhd->bhtm', q, mem_k).astype(jnp.float32) * (d ** -0.5)
    p = jax.nn.softmax(s, axis=-1)
    o = jnp.einsum('bhtm,bmhd->bthd', p.astype(mem_v.dtype), mem_v)
    return o.reshape(B, T, H * d)


def setup_inputs(seed: int = 0) -> dict:
    key = jax.random.key(seed)
    ks = jax.random.split(key, 24)
    L, D = DEPTH, D_MODEL

    def w(k, shape, fan_in):
        return jax.random.normal(k, shape, jnp.float32) * (fan_in ** -0.5)

    def gain(k, shape):
        return 1.0 + 0.02 * jax.random.normal(k, shape, jnp.float32)

    return {
        "x": jax.random.normal(ks[0], (BATCH, SEQ, D), jnp.float32),
        "mem": jax.random.normal(ks[1], (BATCH, N_MEM, D), jnp.float32),
        "attn_norm": gain(ks[2], (L, D)),
        "w_in": w(ks[3], (L, D, IN_W), D),
        "gla_w_a2": w(ks[4], (L, GLA_RANK, GLA_HEADS * GLA_DK), GLA_RANK),
        "gla_b_a": 0.1 * jax.random.normal(ks[5], (L, GLA_HEADS * GLA_DK), jnp.float32),
        "gla_out_norm": gain(ks[6], (L, GLA_DV)),
        "w_br_gla": w(ks[7], (L, GLA_HEADS * GLA_DV, D), GLA_HEADS * GLA_DV),
        "sb_q_norm": gain(ks[8], (L, SB_DH)),
        "sb_k_norm": gain(ks[9], (L, SB_DH)),
        "w_br_sb": w(ks[10], (L, SB_HEADS * SB_DH, D), SB_HEADS * SB_DH),
        "mem_norm": gain(ks[11], (L, D)),
        "w_mem_kv": w(ks[12], (L, D, 2 * MEM_HEADS * MEM_DH), D),
        "mem_q_norm": gain(ks[13], (L, MEM_DH)),
        "mem_k_norm": gain(ks[14], (L, MEM_DH)),
        "w_br_mem": w(ks[15], (L, MEM_HEADS * MEM_DH, D), MEM_HEADS * MEM_DH),
        "w_o": w(ks[16], (L, D, D), D),
        "ffn_norm": gain(ks[17], (L, D)),
        "w_gate_up": w(ks[18], (L, D, 2 * D_FF), D),
        "w_down": w(ks[19], (L, D_FF, D), D_FF),
    }


def reference(x, mem, attn_norm, w_in, gla_w_a2, gla_b_a, gla_out_norm, w_br_gla,
              sb_q_norm, sb_k_norm, w_br_sb, mem_norm, w_mem_kv, mem_q_norm, mem_k_norm,
              w_br_mem, w_o, ffn_norm, w_gate_up, w_down):
    B, T, D = x.shape
    M = mem.shape[1]
    for l in range(DEPTH):
        h = rmsnorm(x, attn_norm[l])
        proj = h @ w_in[l]
        (gq, gk, gv, gr, ga1, sq, sk, sv, mq, gates) = jnp.split(proj, SPLIT_POINTS, axis=-1)

        log_a = jax.nn.log_sigmoid((ga1 @ gla_w_a2[l] + gla_b_a[l]).astype(jnp.float32)) / GLA_TAU
        o_gla = gla_mixer(gq.reshape(B, T, GLA_HEADS, GLA_DK), gk.reshape(B, T, GLA_HEADS, GLA_DK),
                          gv.reshape(B, T, GLA_HEADS, GLA_DV), log_a.reshape(B, T, GLA_HEADS, GLA_DK))
        o_gla = rmsnorm(o_gla, gla_out_norm[l]).reshape(B, T, GLA_HEADS * GLA_DV).astype(x.dtype)
        y_gla = (o_gla * jax.nn.silu(gr)) @ w_br_gla[l]

        q_sb = rmsnorm(sq.reshape(B, T, SB_HEADS, SB_DH), sb_q_norm[l])
        k_sb = rmsnorm(sk.reshape(B, T, SB_HEADS, SB_DH), sb_k_norm[l])
        y_sb = stick_breaking_mixer(q_sb, k_sb, sv.reshape(B, T, SB_HEADS, SB_DH)) @ w_br_sb[l]

        mem_kv = rmsnorm(mem, mem_norm[l]) @ w_mem_kv[l]
        m_k, m_v = jnp.split(mem_kv, 2, axis=-1)
        m_k = rmsnorm(m_k.reshape(B, M, MEM_HEADS, MEM_DH), mem_k_norm[l])
        m_v = m_v.reshape(B, M, MEM_HEADS, MEM_DH)
        q_m = rmsnorm(mq.reshape(B, T, MEM_HEADS, MEM_DH), mem_q_norm[l])
        y_mem = memory_mixer(q_m, m_k, m_v) @ w_br_mem[l]

        g = jax.nn.sigmoid(gates.reshape(B, T, N_BRANCH, D))
        merged = g[:, :, 0] * y_gla + g[:, :, 1] * y_sb + g[:, :, 2] * y_mem
        x = x + merged @ w_o[l]

        h2 = rmsnorm(x, ffn_norm[l])
        gate, up = jnp.split(h2 @ w_gate_up[l], 2, axis=-1)
        x = x + (jax.nn.silu(gate) * up) @ w_down[l]
    return x
```

```cpp
#include <hip/hip_runtime.h>
#include <hip/hip_cooperative_groups.h>
#include <cstdio>
#include <cstdint>
namespace cg = cooperative_groups;

#define LAS __attribute__((address_space(3)))
typedef unsigned short bf16;
typedef short bf16x8 __attribute__((ext_vector_type(8)));
typedef short s16x4 __attribute__((ext_vector_type(4)));
typedef float f32x2 __attribute__((ext_vector_type(2)));
typedef float f32x4 __attribute__((ext_vector_type(4)));
typedef float f32x16 __attribute__((ext_vector_type(16)));
typedef unsigned u32x2 __attribute__((ext_vector_type(2)));
typedef unsigned u32x4 __attribute__((ext_vector_type(4)));

constexpr int T = 16384, DM = 2048, NMEM = 256, DFF = 5632, INW = 13328, NP = 13312, DEPTH = 2;
constexpr float EPS = 1e-6f;
constexpr float LOG2E = 1.4426950408889634f;

constexpr size_t MiB = 1u << 20;
constexpr size_t WS_WIN = 0;
constexpr size_t WS_WBR = 52 * MiB;
constexpr size_t WS_WO = 64 * MiB;
constexpr size_t WS_WGU = 72 * MiB;
constexpr size_t WS_WDN = 116 * MiB;
constexpr size_t WS_WMK = 138 * MiB;
constexpr size_t WS_H = 154 * MiB;
constexpr size_t WS_GQ = 218 * MiB;
constexpr size_t WS_GK = 234 * MiB;
constexpr size_t WS_GV = 250 * MiB;
constexpr size_t WS_GR = 282 * MiB;
constexpr size_t WS_SQ = 314 * MiB;
constexpr size_t WS_SK = 346 * MiB;
constexpr size_t WS_SV = 378 * MiB;
constexpr size_t WS_MQ = 410 * MiB;
constexpr size_t WS_GATES = 442 * MiB;
constexpr size_t WS_ABR = 634 * MiB;
constexpr size_t WS_GA1 = 730 * MiB;
constexpr size_t WS_DEC = 731 * MiB;
constexpr size_t WS_MEMKV = 732 * MiB;
constexpr size_t WS_HM = 736 * MiB;
constexpr size_t WS_KN = 738 * MiB;
constexpr size_t WS_VT = 739 * MiB;
constexpr size_t WS_CTL = 740 * MiB;
constexpr size_t CTL_BYTES = 16384;
constexpr size_t WS_X = 741 * MiB;
constexpr size_t WS_END = 805 * MiB;
constexpr int LDS_BYTES = 147456;

__device__ __forceinline__ unsigned f2bf(float f) { unsigned u = __builtin_bit_cast(unsigned, f); return (u + 0x7fffu + ((u >> 16) & 1u)) >> 16; }
__device__ __forceinline__ unsigned pk2(float lo, float hi) { return f2bf(lo) | (f2bf(hi) << 16); }
__device__ __forceinline__ float bf2f(unsigned short b) { return __builtin_bit_cast(float, ((unsigned)b) << 16); }
__device__ __forceinline__ float bflo(unsigned w) { return __builtin_bit_cast(float, w << 16); }
__device__ __forceinline__ float bfhi(unsigned w) { return __builtin_bit_cast(float, w & 0xffff0000u); }
__device__ __forceinline__ unsigned cvtpk(float lo, float hi) { unsigned r; asm volatile("v_cvt_pk_bf16_f32 %0, %1, %2" : "=v"(r) : "v"(lo), "v"(hi)); return r; }
template <int PAT> __device__ __forceinline__ float swz(float v) { return __builtin_bit_cast(float, __builtin_amdgcn_ds_swizzle(__builtin_bit_cast(int, v), PAT)); }
__device__ __forceinline__ float swap16_sum(float v) { return v + swz<0x401F>(v); }
__device__ __forceinline__ float swap32_sum(float v) {
    const unsigned u = __builtin_bit_cast(unsigned, v); auto r = __builtin_amdgcn_permlane32_swap(u, u, false, false);
    const bool hi = __builtin_amdgcn_mbcnt_lo(~0u, 0u) == 32u; return v + __builtin_bit_cast(float, hi ? r[0] : r[1]); }
template <int CTRL> __device__ __forceinline__ float dppf(float v) { return __builtin_bit_cast(float, __builtin_amdgcn_update_dpp(0, __builtin_bit_cast(int, v), CTRL, 0xf, 0xf, true)); }
__device__ __forceinline__ float red4(float v) { v += dppf<0xB1>(v); v += dppf<0x4E>(v); return v; }
__device__ __forceinline__ float red8(float v) { v = red4(v); v += dppf<0x141>(v); return v; }
__device__ __forceinline__ float red16(float v) { v = red8(v); v += dppf<0x140>(v); return v; }
__device__ __forceinline__ float red32(float v) { return swap16_sum(red16(v)); }
__device__ __forceinline__ float wave_sum(float v) { return swap32_sum(red32(v)); }
__device__ __forceinline__ int crow(int r, int hi) { return (r & 3) + 8 * (r >> 2) + 4 * hi; }
__device__ __forceinline__ int opaque_s(int x) { asm volatile("" : "+s"(x)); return x; }
__device__ __forceinline__ unsigned char* opaque_p(unsigned char* p) { __attribute__((address_space(1))) unsigned char* g = (__attribute__((address_space(1))) unsigned char*)p; asm volatile("" : "+s"(g)); return (unsigned char*)g; }
#define TID() (wv0 * 64 + (int)__builtin_amdgcn_mbcnt_hi(~0u, __builtin_amdgcn_mbcnt_lo(~0u, 0u)))
__device__ __forceinline__ int opaque(int x) { asm volatile("" : "+v"(x)); return x; }
#define LDS_WAIT() asm volatile("s_waitcnt lgkmcnt(0)" ::: "memory")
#define SBAR() __builtin_amdgcn_sched_barrier(0)

namespace pg8 {
#define PG8_LAS __attribute__((address_space(3)))
constexpr int BM = 256, BK = 64, HALF = 128, HTB = HALF * BK * 2, STAGE_BYTES = 8 * HTB, NXCD = 8, WGM = 4;
__host__ __device__ __forceinline__ int lds_byte(int r, int c) { const int st = (r >> 4) * 2 + (c >> 5), rr = r & 15, cc = c & 31, ob = rr * 64 + cc * 2; return st * 1024 + (ob ^ (((ob >> 9) & 1) << 5)); }
__host__ __device__ __forceinline__ void stage_rc(int b, int& R, int& C) { const int st = b / 1024, sb = b % 1024, swz = sb ^ (((sb >> 9) & 1) << 5); R = (st >> 1) * 16 + swz / 64; C = (st & 1) * 32 + (swz % 64) / 2; }
__host__ __device__ __forceinline__ int perm32(int rho) { const int n = rho >> 4, i = rho & 15; return 8 * (i >> 2) + 4 * n + (i & 3); }

struct Unit { int pm, pn, aux; const char* a; const char* b; };
struct Gemm { int K, lda, ldb; };

struct TileOrder {
    int nM, nN, nwg;
    __device__ __forceinline__ void init(int nM_, int nN_) { nM = nM_; nN = nN_; nwg = nM * nN; }
    __device__ __forceinline__ bool get(long L, int& pm, int& pn) const {
        if (L >= nwg) return false;
        int wgid = (int)L; { const int q = nwg / NXCD, r = nwg % NXCD, xcd = wgid % NXCD, off = wgid / NXCD; wgid = (xcd < r ? xcd * (q + 1) : r * (q + 1) + (xcd - r) * q) + off; }
        const int nig = WGM * nN, gid = wgid / nig, fm = gid * WGM, gsz = (nM - fm) < WGM ? (nM - fm) : WGM;
        pm = fm + ((wgid % nig) % gsz); pn = (wgid % nig) / gsz; return true;
    }
};
struct SchedGrid {
    TileOrder to; int G, c; const char* A; const char* B; size_t ta, tb;
    __device__ __forceinline__ bool next(int i, Unit& u) const { int pm, pn; if (!to.get((long)i * G + c, pm, pn)) return false; u.pm = pm; u.pn = pn; u.aux = 0; u.a = A + (size_t)pm * ta; u.b = B + (size_t)pn * tb; return true; }
};
struct SchedBranch {
    TileOrder to; int G, c; const char* A; const char* B;
    __device__ __forceinline__ bool next(int i, Unit& u) const { int pm, pn; const int tl = i / 3, br = i - tl * 3; if (!to.get((long)tl * G + c, pm, pn)) return false; u.pm = pm; u.pn = pn; u.aux = br;
        u.a = A + ((size_t)br * T + (size_t)pm * 256) * 1024 * 2; u.b = B + ((size_t)br * 2048 + (size_t)pn * 256) * 1024 * 2; return true; }
};
struct SchedOne {
    Unit one;
    __device__ __forceinline__ bool next(int i, Unit& u) const { if (i != 0) return false; u = one; return true; }
};

__device__ __forceinline__ float sigmoid_f(float x) { return __builtin_amdgcn_rcpf(1.0f + __builtin_amdgcn_exp2f(-x * LOG2E)); }

struct EpiProj {
    static constexpr bool PERM = true, AFTER_DRAIN = false;
    unsigned char* ws;
    __device__ __forceinline__ void operator()(const f32x4 (&acc)[2][2][4][2], const Unit& u, int wr, int wc, int fr, int fq) const {
        const int row0 = u.pm * BM + wr * 64 + fr; int colt = u.pn * BM; bf16* base; int ld; bool sg = false;
        if (colt < 512) { base = (bf16*)(ws + WS_GQ); ld = 512; }
        else if (colt < 1024) { base = (bf16*)(ws + WS_GK); ld = 512; colt -= 512; }
        else if (colt < 2048) { base = (bf16*)(ws + WS_GV); ld = 1024; colt -= 1024; }
        else if (colt < 3072) { base = (bf16*)(ws + WS_GR); ld = 1024; colt -= 2048; }
        else if (colt < 7168) { const int blk = (colt - 3072) >> 10; base = (bf16*)(ws + WS_SQ) + (size_t)blk * T * 1024; ld = 1024; colt = (colt - 3072) & 1023; }
        else { base = (bf16*)(ws + WS_GATES); ld = 6144; colt -= 7168; sg = true; }
        const int col0 = colt + wc * 32 + 8 * fq;
        if (sg) {
            const int tidx = ((wr * 4 + wc) * 64 + fq * 16 + fr);
            u32x2* gb = (u32x2*)(ws + WS_GATES) + ((size_t)(u.pm * 24 + (u.pn - 28)) * 16) * 512 + tidx;
#pragma unroll
            for (int ai = 0; ai < 2; ++ai)
#pragma unroll
                for (int m = 0; m < 4; ++m)
#pragma unroll
                    for (int bj = 0; bj < 2; ++bj) { const f32x4 v0 = acc[ai][bj][m][0], v1 = acc[ai][bj][m][1]; unsigned lo = 0u, hi = 0u;
#pragma unroll
                        for (int j = 0; j < 4; ++j) { lo |= max((unsigned)(sigmoid_f(v0[j]) * 255.0f + 0.5f), 1u) << (8 * j); hi |= max((unsigned)(sigmoid_f(v1[j]) * 255.0f + 0.5f), 1u) << (8 * j); }
                        u32x2 w; w.x = lo; w.y = hi; gb[(size_t)((ai * 4 + m) * 2 + bj) * 512] = w; }
            return;
        }
#pragma unroll
        for (int ai = 0; ai < 2; ++ai)
#pragma unroll
            for (int m = 0; m < 4; ++m) { bf16* rowp = base + (size_t)(row0 + ai * HALF + m * 16) * ld + col0;
#pragma unroll
                for (int bj = 0; bj < 2; ++bj) { f32x4 v0 = acc[ai][bj][m][0], v1 = acc[ai][bj][m][1];
                    if (sg) {
#pragma unroll
                        for (int j = 0; j < 4; ++j) { v0[j] = sigmoid_f(v0[j]); v1[j] = sigmoid_f(v1[j]); } }
                    u32x4 w; w.x = cvtpk(v0[0], v0[1]); w.y = cvtpk(v0[2], v0[3]); w.z = cvtpk(v1[0], v1[1]); w.w = cvtpk(v1[2], v1[3]);
                    *(u32x4*)(rowp + bj * HALF) = w; } }
    }
};
struct EpiBf16 {
    static constexpr bool PERM = true, AFTER_DRAIN = false;
    bf16* O; int ldc;
    __device__ __forceinline__ void operator()(const f32x4 (&acc)[2][2][4][2], const Unit& u, int wr, int wc, int fr, int fq) const {
        const int row0 = u.pm * BM + wr * 64 + fr; const int col0 = u.pn * BM + wc * 32 + 8 * fq;
#pragma unroll
        for (int ai = 0; ai < 2; ++ai)
#pragma unroll
            for (int m = 0; m < 4; ++m) { bf16* rowp = O + (size_t)(row0 + ai * HALF + m * 16) * ldc + col0;
#pragma unroll
                for (int bj = 0; bj < 2; ++bj) { const f32x4 v0 = acc[ai][bj][m][0], v1 = acc[ai][bj][m][1];
                    u32x4 w; w.x = cvtpk(v0[0], v0[1]); w.y = cvtpk(v0[2], v0[3]); w.z = cvtpk(v1[0], v1[1]); w.w = cvtpk(v1[2], v1[3]);
                    *(u32x4*)(rowp + bj * HALF) = w; } }
    }
};
struct EpiSwiglu {
    static constexpr bool PERM = true, AFTER_DRAIN = false;
    bf16* O;
    __device__ __forceinline__ void operator()(const f32x4 (&acc)[2][2][4][2], const Unit& u, int wr, int wc, int fr, int fq) const {
        const int row0 = u.pm * BM + wr * 64 + fr; const int col0 = u.pn * HALF + wc * 32 + 8 * fq;
#pragma unroll
        for (int ai = 0; ai < 2; ++ai)
#pragma unroll
            for (int m = 0; m < 4; ++m) { bf16* rowp = O + (size_t)(row0 + ai * HALF + m * 16) * DFF + col0;
                f32x4 g0 = acc[ai][0][m][0], g1 = acc[ai][0][m][1]; const f32x4 u0 = acc[ai][1][m][0], u1 = acc[ai][1][m][1];
#pragma unroll
                for (int j = 0; j < 4; ++j) { g0[j] = g0[j] * sigmoid_f(g0[j]) * u0[j]; g1[j] = g1[j] * sigmoid_f(g1[j]) * u1[j]; }
                u32x4 w; w.x = cvtpk(g0[0], g0[1]); w.y = cvtpk(g0[2], g0[3]); w.z = cvtpk(g1[0], g1[1]); w.w = cvtpk(g1[2], g1[3]);
                *(u32x4*)rowp = w; }
    }
};
struct EpiMerge {
    static constexpr bool PERM = true, AFTER_DRAIN = false, KEEP_ACC = true;
    const unsigned char* gates; bf16* mg;
    __device__ __forceinline__ void operator()(const f32x4 (&)[2][2][4][2], const Unit&, int, int, int, int) const {}
    __device__ __forceinline__ void mid(f32x4 (&acc)[2][2][4][2], const Unit& u, int wr, int wc, int fr, int fq) const {
        const int row0 = u.pm * BM + wr * 64 + fr; const int col0 = u.pn * BM + wc * 32 + 8 * fq; const int br = u.aux;
        const int tidx = (wr * 4 + wc) * 64 + fq * 16 + fr;
        const u32x2* gnum = (const u32x2*)gates + ((size_t)(u.pm * 24 + br * 8 + u.pn) * 16) * 512 + tidx;
        const u32x2* gden = (const u32x2*)gates + ((size_t)(u.pm * 24 + (br < 2 ? br + 1 : 2) * 8 + u.pn) * 16) * 512 + tidx;
#pragma unroll
        for (int ai = 0; ai < 2; ++ai) {
            u32x2 gn[8], gd[8];
#pragma unroll
            for (int q = 0; q < 8; ++q) { gn[q] = gnum[(size_t)(ai * 8 + q) * 512]; if (br < 2) gd[q] = gden[(size_t)(ai * 8 + q) * 512]; }
#pragma unroll
            for (int m = 0; m < 4; ++m)
#pragma unroll
                for (int bj = 0; bj < 2; ++bj) { const int q = m * 2 + bj; const u32x2 n = gn[q]; f32x4 s0, s1;
                    s0[0] = (float)(n.x & 0xffu); s0[1] = (float)((n.x >> 8) & 0xffu); s0[2] = (float)((n.x >> 16) & 0xffu); s0[3] = (float)(n.x >> 24);
                    s1[0] = (float)(n.y & 0xffu); s1[1] = (float)((n.y >> 8) & 0xffu); s1[2] = (float)((n.y >> 16) & 0xffu); s1[3] = (float)(n.y >> 24);
                    if (br < 2) { const u32x2 d = gd[q];
                        s0[0] *= __builtin_amdgcn_rcpf((float)(d.x & 0xffu)); s0[1] *= __builtin_amdgcn_rcpf((float)((d.x >> 8) & 0xffu)); s0[2] *= __builtin_amdgcn_rcpf((float)((d.x >> 16) & 0xffu)); s0[3] *= __builtin_amdgcn_rcpf((float)(d.x >> 24));
                        s1[0] *= __builtin_amdgcn_rcpf((float)(d.y & 0xffu)); s1[1] *= __builtin_amdgcn_rcpf((float)((d.y >> 8) & 0xffu)); s1[2] *= __builtin_amdgcn_rcpf((float)((d.y >> 16) & 0xffu)); s1[3] *= __builtin_amdgcn_rcpf((float)(d.y >> 24));
                        acc[ai][bj][m][0] *= s0; acc[ai][bj][m][1] *= s1;
                    } else { constexpr float I255 = 1.0f / 255.0f; const f32x4 v0 = acc[ai][bj][m][0] * s0 * I255, v1 = acc[ai][bj][m][1] * s1 * I255;
                        u32x4 w; w.x = cvtpk(v0[0], v0[1]); w.y = cvtpk(v0[2], v0[3]); w.z = cvtpk(v1[0], v1[1]); w.w = cvtpk(v1[2], v1[3]);
                        *(u32x4*)(mg + (size_t)(row0 + ai * HALF + m * 16) * 2048 + col0 + bj * HALF) = w;
                        acc[ai][bj][m][0] = (f32x4){0.f, 0.f, 0.f, 0.f}; acc[ai][bj][m][1] = (f32x4){0.f, 0.f, 0.f, 0.f}; } }
        }
    }
};
template <bool BASE_BF, bool OUT_BF>
struct EpiRes {
    static constexpr bool PERM = true, AFTER_DRAIN = false;
    const void* base; void* out;
    __device__ __forceinline__ void operator()(const f32x4 (&acc)[2][2][4][2], const Unit& u, int wr, int wc, int fr, int fq) const {
        const int row0 = u.pm * BM + wr * 64 + fr, col0 = u.pn * BM + wc * 32 + 8 * fq;
#pragma unroll
        for (int ai = 0; ai < 2; ++ai)
#pragma unroll
            for (int mp = 0; mp < 2; ++mp) {
                f32x4 b0[2][2], b1[2][2];
#pragma unroll
                for (int mm = 0; mm < 2; ++mm)
#pragma unroll
                    for (int bj = 0; bj < 2; ++bj) { const size_t off = (size_t)(row0 + ai * HALF + (2 * mp + mm) * 16) * 2048 + col0 + bj * HALF;
                        if (BASE_BF) { const u32x4 w = *(const u32x4*)((const bf16*)base + off);
                            b0[mm][bj] = (f32x4){bflo(w.x), bfhi(w.x), bflo(w.y), bfhi(w.y)}; b1[mm][bj] = (f32x4){bflo(w.z), bfhi(w.z), bflo(w.w), bfhi(w.w)}; }
                        else { b0[mm][bj] = *(const f32x4*)((const float*)base + off); b1[mm][bj] = *(const f32x4*)((const float*)base + off + 4); } }
#pragma unroll
                for (int mm = 0; mm < 2; ++mm)
#pragma unroll
                    for (int bj = 0; bj < 2; ++bj) { const int m = 2 * mp + mm; const size_t off = (size_t)(row0 + ai * HALF + m * 16) * 2048 + col0 + bj * HALF;
                        const f32x4 v0 = b0[mm][bj] + acc[ai][bj][m][0], v1 = b1[mm][bj] + acc[ai][bj][m][1];
                        if (OUT_BF) { u32x4 w; w.x = cvtpk(v0[0], v0[1]); w.y = cvtpk(v0[2], v0[3]); w.z = cvtpk(v1[0], v1[1]); w.w = cvtpk(v1[2], v1[3]); *(u32x4*)((bf16*)out + off) = w; }
                        else { *(f32x4*)((float*)out + off) = v0; *(f32x4*)((float*)out + off + 4) = v1; } }
            }
    }
};
struct EpiSoftmax {
    static constexpr bool PERM = true, AFTER_DRAIN = true;
    bf16* P;
    __device__ __forceinline__ void operator()(const f32x4 (&)[2][2][4][2], const Unit&, int, int, int, int) const {}
    __device__ __forceinline__ void fused(f32x4 (&acc)[2][2][4][2], const Unit& u, int wr, int wc, int fr, int fq, PG8_LAS unsigned char* lds, int wid, int lane) const {
        PG8_LAS float* S = (PG8_LAS float*)lds;
#pragma unroll
        for (int ai = 0; ai < 2; ++ai)
#pragma unroll
            for (int m = 0; m < 4; ++m) { float s = 0.f;
#pragma unroll
                for (int bj = 0; bj < 2; ++bj)
#pragma unroll
                    for (int n = 0; n < 2; ++n) { f32x4 x = acc[ai][bj][m][n];
#pragma unroll
                        for (int j = 0; j < 4; ++j) x[j] = __builtin_amdgcn_exp2f(x[j]);
                        acc[ai][bj][m][n] = x; s += (x[0] + x[1]) + (x[2] + x[3]); }
                s = swap32_sum(swap16_sum(s));
                if (fq == 0) S[(ai * HALF + wr * 64 + m * 16 + fr) * 4 + wc] = s; }
        asm volatile("s_waitcnt lgkmcnt(0)" ::: "memory"); __builtin_amdgcn_s_barrier(); asm volatile("" ::: "memory");
        const int row0 = u.pm * BM + wr * 64 + fr; const int col0 = u.pn * BM + wc * 32 + 8 * fq;
#pragma unroll
        for (int ai = 0; ai < 2; ++ai)
#pragma unroll
            for (int m = 0; m < 4; ++m) { const int rl = ai * HALF + wr * 64 + m * 16 + fr; const f32x4 pp = *(const PG8_LAS f32x4*)(S + rl * 4);
                const float rinv = 1.0f / ((pp[0] + pp[1]) + (pp[2] + pp[3]));
                bf16* rowp = P + (size_t)(row0 + ai * HALF + m * 16) * 1024 + col0;
#pragma unroll
                for (int bj = 0; bj < 2; ++bj) { const f32x4 v0 = acc[ai][bj][m][0] * rinv, v1 = acc[ai][bj][m][1] * rinv;
                    u32x4 w; w.x = cvtpk(v0[0], v0[1]); w.y = cvtpk(v0[2], v0[3]); w.z = cvtpk(v1[0], v1[1]); w.w = cvtpk(v1[2], v1[3]);
                    *(u32x4*)(rowp + bj * HALF) = w; } }
    }
};

template <class E, class = void> struct epi_keeps_acc { static constexpr bool value = false; };
template <class E> struct epi_keeps_acc<E, decltype((void)E::KEEP_ACC)> { static constexpr bool value = E::KEEP_ACC; };
template <class Epi, class Sched, bool ALIGN_EPI = false, bool SP2 = false>
__device__ __forceinline__ void gemm_phase(PG8_LAS unsigned char* lds, const Gemm g, const Sched& S, const Epi& E, const int wv0) {
    const int tid = opaque(TID()), wid = __builtin_amdgcn_readfirstlane(tid >> 6), lane = tid & 63, wr = wid >> 2, wc = wid & 3, fr = lane & 15, fq = lane >> 4;
    const int K = g.K, nt = K / BK;
    unsigned voffA[2], voffB[2];
#pragma unroll
    for (int i = 0; i < 2; ++i) { int R, C; stage_rc(tid * 16 + i * 8192, R, C); const int Rb = Epi::PERM ? ((R & ~31) + perm32(R & 31)) : R;
        voffA[i] = (unsigned)(R * g.lda + C) * 2u; voffB[i] = (unsigned)(Rb * g.ldb + C) * 2u; }
    const size_t kstep = (size_t)(BK * 2);
    const size_t hstepA = (size_t)HALF * g.lda * 2, hstepB = (size_t)HALF * g.ldb * 2;
    const unsigned ldsw = (unsigned)wid * 1024u;
    const int aoff = lds_byte(wr * 64 + fr, fq * 8), boff = lds_byte(wc * 32 + fr, fq * 8);
#define PG8_SA(b, h) (((b) * 2 + (h)) * HTB)
#define PG8_SB(b, h) ((4 + (b) * 2 + (h)) * HTB)
#define PG8_STAGE(bufoff, gbase, voff) do { _Pragma("unroll") for (int _i = 0; _i < 2; ++_i) \
        __builtin_amdgcn_global_load_lds((const unsigned*)((const char*)(gbase) + (voff)[_i]), (PG8_LAS unsigned*)(lds + (bufoff) + ldsw + _i * 8192), 16, 0, 0); } while (0)
#define PG8_LDA(dst, b, h) do { _Pragma("unroll") for (int m = 0; m < 4; ++m) _Pragma("unroll") for (int k = 0; k < 2; ++k) dst[m][k] = *(const PG8_LAS bf16x8*)(lds + PG8_SA(b, h) + aoff + m * 2048 + k * 1024); } while (0)
#define PG8_LDB(dst, b, h) do { _Pragma("unroll") for (int n = 0; n < 2; ++n) _Pragma("unroll") for (int k = 0; k < 2; ++k) dst[n][k] = *(const PG8_LAS bf16x8*)(lds + PG8_SB(b, h) + boff + n * 2048 + k * 1024); } while (0)
#define PG8_MMA(ai, bj, At, Bt) do { __builtin_amdgcn_s_setprio(1); _Pragma("unroll") for (int m = 0; m < 4; ++m) _Pragma("unroll") for (int n = 0; n < 2; ++n) _Pragma("unroll") for (int k = 0; k < 2; ++k) \
        acc[ai][bj][m][n] = __builtin_amdgcn_mfma_f32_16x16x32_bf16(Bt[n][k], At[m][k], acc[ai][bj][m][n], 0, 0, 0); __builtin_amdgcn_s_setprio(0); } while (0)
#define PG8_WAIT_V(n) asm volatile("s_waitcnt vmcnt(" #n ")" ::: "memory")
#define PG8_WAIT_L(n) asm volatile("s_waitcnt lgkmcnt(" #n ")" ::: "memory")
#define PG8_BAR __builtin_amdgcn_s_barrier()
#define PG8_SCHED __builtin_amdgcn_sched_barrier(0)
    Unit cur, nxt; int ui = 0;
    if (!S.next(0, cur)) return;
    f32x4 acc[2][2][4][2];
#pragma unroll
    for (int a = 0; a < 2; ++a)
#pragma unroll
        for (int b = 0; b < 2; ++b)
#pragma unroll
            for (int m = 0; m < 4; ++m)
#pragma unroll
                for (int n = 0; n < 2; ++n) acc[a][b][m][n] = (f32x4){0.f, 0.f, 0.f, 0.f};
    bf16x8 At[4][2], B0[2][2], B1[2][2];
    const char* cA = cur.a; const char* cB = cur.b;
    if constexpr (SP2) {
        PG8_STAGE(PG8_SB(0, 0), cB, voffB); PG8_STAGE(PG8_SB(0, 1), cB + hstepB, voffB); PG8_STAGE(PG8_SA(0, 0), cA, voffA); PG8_STAGE(PG8_SA(0, 1), cA + hstepA, voffA);
        if (wr == 1) PG8_BAR;
        PG8_WAIT_V(2); PG8_BAR;
        PG8_STAGE(PG8_SB(1, 0), cB + kstep, voffB); PG8_STAGE(PG8_SA(1, 0), cA + kstep, voffA); PG8_STAGE(PG8_SB(1, 1), cB + hstepB + kstep, voffB);
        PG8_WAIT_V(6); PG8_BAR;
    } else {
        PG8_STAGE(PG8_SB(0, 0), cB, voffB); PG8_STAGE(PG8_SA(0, 0), cA, voffA); PG8_STAGE(PG8_SB(0, 1), cB + hstepB, voffB); PG8_STAGE(PG8_SA(0, 1), cA + hstepA, voffA);
        if (wr == 1) PG8_BAR;
        PG8_WAIT_V(4); PG8_BAR;
        PG8_STAGE(PG8_SB(1, 0), cB + kstep, voffB); PG8_STAGE(PG8_SA(1, 0), cA + kstep, voffA); PG8_STAGE(PG8_SB(1, 1), cB + hstepB + kstep, voffB);
        PG8_WAIT_V(6); PG8_BAR;
    }
    for (;;) {
        const bool has_next = S.next(ui + 1, nxt);
        const char* nA = has_next ? nxt.a : cA; const char* nB = has_next ? nxt.b : cB;
        for (int t = 0; t < nt; t += 2) {
            const bool last = (t == nt - 2);
            const char* a1 = cA + (size_t)(t + 1) * kstep;
            const char* a2 = last ? nA : cA + (size_t)(t + 2) * kstep; const char* b2 = last ? nB : cB + (size_t)(t + 2) * kstep;
            const char* a3 = a2 + kstep; const char* b3 = b2 + kstep;
            if constexpr (SP2) {
            PG8_LDB(B0, 0, 0); PG8_LDB(B1, 0, 1); PG8_SCHED; PG8_LDA(At, 0, 0); PG8_STAGE(PG8_SA(1, 1), a1 + hstepA, voffA);
            PG8_WAIT_V(8); PG8_WAIT_L(0); PG8_BAR; PG8_MMA(0, 0, At, B0); PG8_MMA(0, 1, At, B1); PG8_BAR; PG8_SCHED;
            PG8_LDA(At, 0, 1); PG8_STAGE(PG8_SB(0, 0), b2, voffB); PG8_STAGE(PG8_SB(0, 1), b2 + hstepB, voffB); PG8_STAGE(PG8_SA(0, 0), a2, voffA);
            PG8_WAIT_V(8); PG8_WAIT_L(0); PG8_BAR; PG8_MMA(1, 0, At, B0); PG8_MMA(1, 1, At, B1); PG8_BAR; PG8_SCHED;
            PG8_LDB(B0, 1, 0); PG8_LDB(B1, 1, 1); PG8_SCHED; PG8_LDA(At, 1, 0); PG8_STAGE(PG8_SA(0, 1), a2 + hstepA, voffA);
            PG8_WAIT_V(8); PG8_WAIT_L(0); PG8_BAR; PG8_MMA(0, 0, At, B0); PG8_MMA(0, 1, At, B1); PG8_BAR; PG8_SCHED;
            PG8_LDA(At, 1, 1); PG8_STAGE(PG8_SB(1, 0), b3, voffB); PG8_STAGE(PG8_SB(1, 1), b3 + hstepB, voffB); PG8_STAGE(PG8_SA(1, 0), a3, voffA);
            PG8_WAIT_V(8); PG8_WAIT_L(0); PG8_BAR; PG8_MMA(1, 0, At, B0); PG8_MMA(1, 1, At, B1); PG8_BAR; PG8_SCHED;
            } else {
            PG8_LDB(B0, 0, 0); PG8_SCHED; PG8_LDA(At, 0, 0); PG8_STAGE(PG8_SA(1, 1), a1 + hstepA, voffA);
            PG8_WAIT_L(8); PG8_BAR; PG8_WAIT_L(0); PG8_MMA(0, 0, At, B0); PG8_BAR; PG8_SCHED;
            PG8_LDB(B1, 0, 1); PG8_STAGE(PG8_SB(0, 0), b2, voffB);
            PG8_BAR; PG8_WAIT_L(0); PG8_MMA(0, 1, At, B1); PG8_BAR;
            PG8_LDA(At, 0, 1); PG8_STAGE(PG8_SA(0, 0), a2, voffA);
            PG8_BAR; PG8_WAIT_L(0); PG8_MMA(1, 0, At, B0); PG8_BAR; PG8_SCHED;
            PG8_STAGE(PG8_SB(0, 1), b2 + hstepB, voffB);
            PG8_WAIT_V(6); PG8_BAR; PG8_MMA(1, 1, At, B1); PG8_BAR;
            PG8_LDB(B0, 1, 0); PG8_SCHED; PG8_LDA(At, 1, 0); PG8_STAGE(PG8_SA(0, 1), a2 + hstepA, voffA);
            PG8_WAIT_L(8); PG8_BAR; PG8_WAIT_L(0); PG8_MMA(0, 0, At, B0); PG8_BAR; PG8_SCHED;
            PG8_LDB(B1, 1, 1); PG8_STAGE(PG8_SB(1, 0), b3, voffB);
            PG8_BAR; PG8_WAIT_L(0); PG8_MMA(0, 1, At, B1); PG8_BAR;
            PG8_LDA(At, 1, 1); PG8_STAGE(PG8_SA(1, 0), a3, voffA);
            PG8_BAR; PG8_WAIT_L(0); PG8_MMA(1, 0, At, B0); PG8_BAR; PG8_SCHED;
            PG8_STAGE(PG8_SB(1, 1), b3 + hstepB, voffB);
            PG8_WAIT_V(6); PG8_BAR; PG8_MMA(1, 1, At, B1); PG8_BAR;
            }
        }
        if constexpr (ALIGN_EPI) { if (wr == 0) PG8_BAR; }
        if constexpr (epi_keeps_acc<Epi>::value) { E.mid(acc, cur, wr, wc, fr, fq); } else if constexpr (!Epi::AFTER_DRAIN) { E(acc, cur, wr, wc, fr, fq); }
        if (!has_next) break;
        if constexpr (!epi_keeps_acc<Epi>::value) {
#pragma unroll
        for (int a = 0; a < 2; ++a)
#pragma unroll
            for (int b = 0; b < 2; ++b)
#pragma unroll
                for (int m = 0; m < 4; ++m)
#pragma unroll
                    for (int n = 0; n < 2; ++n) acc[a][b][m][n] = (f32x4){0.f, 0.f, 0.f, 0.f};
        }
        cur = nxt; cA = nA; cB = nB; ++ui;
        if constexpr (ALIGN_EPI) { if (wr == 1) PG8_BAR; }
    }
    PG8_WAIT_V(0);
    if constexpr (!ALIGN_EPI) { if (wr == 0) PG8_BAR; }
    PG8_BAR;
    if constexpr (Epi::AFTER_DRAIN) { E.fused(acc, cur, wr, wc, fr, fq, lds, wid, lane); }
#undef PG8_SA
#undef PG8_SB
#undef PG8_STAGE
#undef PG8_LDA
#undef PG8_LDB
#undef PG8_MMA
#undef PG8_WAIT_V
#undef PG8_WAIT_L
#undef PG8_BAR
#undef PG8_SCHED
}
}

namespace sba {
constexpr int KVBLK = 64, LD = 1024;
constexpr size_t SHM_V = KVBLK * 128 * 2, SHM_K = KVBLK * 128 * 2;
#define KSWZ(row, colB) ((row) * 256 + ((colB) ^ (((row) & 7) << 4)))
__device__ __forceinline__ void qkt(f32x16& p0, f32x16& p1, const char* Ks, const bf16x8* qr, int r32, int hi) {
    p0 = f32x16{}; p1 = f32x16{};
#pragma unroll
    for (int d0 = 0; d0 < 8; ++d0) { const int cb = (d0 * 16 + hi * 8) * 2;
        const bf16x8 b0 = *reinterpret_cast<const bf16x8*>(Ks + KSWZ(r32, cb));
        const bf16x8 b1 = *reinterpret_cast<const bf16x8*>(Ks + KSWZ(32 + r32, cb));
        p0 = __builtin_amdgcn_mfma_f32_32x32x16_bf16(b0, qr[d0], p0, 0, 0, 0);
        p1 = __builtin_amdgcn_mfma_f32_32x32x16_bf16(b1, qr[d0], p1, 0, 0, 0); }
}
__device__ __forceinline__ int v_st(int k, int c) { const int kk = (k & ~0xC) | ((k & 4) << 1) | ((k & 8) >> 1); return ((kk >> 3) * 4 + (c >> 5)) * 512 + ((kk & 7) * 32 + (c & 31)) * 2; }
__device__ __forceinline__ int v_rd_base(int lane) { return ((lane & 3) << 3) | (((lane >> 2) & 3) << 6) | (((lane >> 4) & 1) << 5) | (((lane >> 5) & 1) << 8); }
constexpr int v_rd_off(int d0, int ks, int half) { return d0 * 512 + ks * 4096 + half * 2048; }
template <int OFF> __device__ __forceinline__ s16x4 tr_read(int vb) {
    s16x4 r; asm volatile("ds_read_b64_tr_b16 %0, %1 offset:%2" : "=&v"(r) : "v"(vb), "i"(OFF) : "memory"); return r;
}
template <int D0> __device__ __forceinline__ void pv_one(f32x16& od, int vb, bf16x8 pa0, bf16x8 pa1, bf16x8 pa2, bf16x8 pa3) {
    const s16x4 l0 = tr_read<v_rd_off(D0, 0, 0)>(vb), h0 = tr_read<v_rd_off(D0, 0, 1)>(vb), l1 = tr_read<v_rd_off(D0, 1, 0)>(vb), h1 = tr_read<v_rd_off(D0, 1, 1)>(vb);
    const s16x4 l2 = tr_read<v_rd_off(D0, 2, 0)>(vb), h2 = tr_read<v_rd_off(D0, 2, 1)>(vb), l3 = tr_read<v_rd_off(D0, 3, 0)>(vb), h3 = tr_read<v_rd_off(D0, 3, 1)>(vb);
    asm volatile("s_waitcnt lgkmcnt(0)" ::: "memory"); SBAR();
#define PK(L, H) (bf16x8){L[0], L[1], L[2], L[3], H[0], H[1], H[2], H[3]}
    od = __builtin_amdgcn_mfma_f32_32x32x16_bf16(pa0, PK(l0, h0), od, 0, 0, 0);
    od = __builtin_amdgcn_mfma_f32_32x32x16_bf16(pa1, PK(l1, h1), od, 0, 0, 0);
    od = __builtin_amdgcn_mfma_f32_32x32x16_bf16(pa2, PK(l2, h2), od, 0, 0, 0);
    od = __builtin_amdgcn_mfma_f32_32x32x16_bf16(pa3, PK(l3, h3), od, 0, 0, 0);
#undef PK
}
__device__ __forceinline__ void pv_d0(f32x16* o, int vb, bf16x8 pa0, bf16x8 pa1, bf16x8 pa2, bf16x8 pa3) {
    pv_one<0>(o[0], vb, pa0, pa1, pa2, pa3); pv_one<1>(o[1], vb, pa0, pa1, pa2, pa3); pv_one<2>(o[2], vb, pa0, pa1, pa2, pa3); pv_one<3>(o[3], vb, pa0, pa1, pa2, pa3);
}
__device__ __forceinline__ void sb_half(f32x16& p, float& carry, bool masked, int krow0, int tq, int hi) {
    float G[4];
#pragma unroll
    for (int g = 0; g < 4; ++g) {
        float q[4];
#pragma unroll
        for (int i = 0; i < 4; ++i) { const int r = 4 * g + i; const float e = __builtin_amdgcn_exp2f(p[r]); float qq = __builtin_amdgcn_rcpf(1.0f + e); float b = e * qq;
            if (masked) { const bool keep = (krow0 + crow(r, hi)) < tq; qq = keep ? qq : 1.0f; b = keep ? b : 0.0f; }
            q[i] = qq; p[r] = b; }
        const float s2 = q[3] * q[2], s1 = s2 * q[1]; G[g] = s1 * q[0];
        p[4 * g + 2] *= q[3]; p[4 * g + 1] *= s2; p[4 * g] *= s1;
    }
    float run = carry;
#pragma unroll
    for (int g = 3; g >= 0; --g) { const unsigned gu = __builtin_bit_cast(unsigned, G[g]); auto sw = __builtin_amdgcn_permlane32_swap(gu, gu, false, false);
        const float partner = __builtin_bit_cast(float, hi ? sw[0] : sw[1]);
        const float base = hi ? run : run * partner;
        p[4 * g] *= base; p[4 * g + 1] *= base; p[4 * g + 2] *= base; p[4 * g + 3] *= base; run *= G[g] * partner; }
    carry = run;
}
__device__ __forceinline__ void pack_p(const f32x16& p0, const f32x16& p1, bf16x8& pa0, bf16x8& pa1, bf16x8& pa2, bf16x8& pa3) {
#define PK4(P, BASE, OUT) do { unsigned a0 = cvtpk(P[BASE + 0], P[BASE + 1]), a1 = cvtpk(P[BASE + 2], P[BASE + 3]);   \
    unsigned b0 = cvtpk(P[BASE + 4], P[BASE + 5]), b1 = cvtpk(P[BASE + 6], P[BASE + 7]);                              \
    auto r0 = __builtin_amdgcn_permlane32_swap(a0, b0, false, false); auto r1 = __builtin_amdgcn_permlane32_swap(a1, b1, false, false); \
    u32x4 w = {r0[0], r1[0], r0[1], r1[1]}; OUT = *reinterpret_cast<bf16x8*>(&w); } while (0)
    PK4(p0, 0, pa0); PK4(p0, 8, pa1); PK4(p1, 0, pa2); PK4(p1, 8, pa3);
#undef PK4
}
__device__ __forceinline__ void sb_unit(const bf16* __restrict__ Qb, const bf16* __restrict__ Kh, const bf16* __restrict__ Vh, bf16* __restrict__ Ob, int q0, char* lds, const int wv0) {
    const int tid = opaque(TID()), wid = tid >> 6, lane = tid & 63, r32 = lane & 31, hi = lane >> 5;
    char* V_lds = lds; char* K_lds = lds + 2 * SHM_V;
    const int NT = (q0 + 256) / KVBLK;
    f32x16 o[4] = {}; bf16x8 qr[8];
    const int tq = q0 + wid * 32 + r32;
    const bf16* Qw = Qb + (size_t)tq * LD + hi * 8;
#pragma unroll
    for (int d0 = 0; d0 < 8; ++d0) qr[d0] = *reinterpret_cast<const bf16x8*>(Qw + d0 * 16);
    const int sr = tid >> 4, sc = (tid & 15) * 8, vst0 = v_st(sr, sc), vst1 = v_st(32 + sr, sc);
    const int vb0 = (int)(uintptr_t)V_lds + v_rd_base(lane);
    struct { bf16x8 vs0, vs1, ks0, ks1; } sr_[1];
#define K0(i) ((NT - 1 - (i)) * KVBLK)
#define SLOAD(i, k0) do { sr_[i].vs0 = *reinterpret_cast<const bf16x8*>(&Vh[(size_t)((k0) + sr) * LD + sc]); sr_[i].vs1 = *reinterpret_cast<const bf16x8*>(&Vh[(size_t)((k0) + 32 + sr) * LD + sc]); \
    sr_[i].ks0 = *reinterpret_cast<const bf16x8*>(&Kh[(size_t)((k0) + sr) * LD + sc]); sr_[i].ks1 = *reinterpret_cast<const bf16x8*>(&Kh[(size_t)((k0) + 32 + sr) * LD + sc]); } while (0)
#define SWRITE(b, i) do { *(bf16x8*)(V_lds + (b) * SHM_V + vst0) = sr_[i].vs0; *(bf16x8*)(V_lds + (b) * SHM_V + vst1) = sr_[i].vs1; const int kc = sc * 2; \
    *(bf16x8*)(K_lds + (b) * SHM_K + KSWZ(sr, kc)) = sr_[i].ks0; *(bf16x8*)(K_lds + (b) * SHM_K + KSWZ(32 + sr, kc)) = sr_[i].ks1; } while (0)
#define SWAIT() asm volatile("s_waitcnt vmcnt(0)" ::: "memory")
    f32x16 pA0, pA1, pB0, pB1; bf16x8 pa0, pa1, pa2, pa3; float carry = 1.0f;
    constexpr int SE = 0, SO = 0;
    __syncthreads();
    SLOAD(SE, K0(0)); asm volatile("s_waitcnt vmcnt(0)" ::: "memory"); SWRITE(0, SE); __syncthreads();
    qkt(pA0, pA1, K_lds, qr, r32, hi); sb_half(pA1, carry, true, K0(0) + 32, tq, hi);
    SLOAD(SO, K0(1));
    SWAIT(); SWRITE(1, SO); __syncthreads();
    volatile unsigned* votes = (volatile unsigned*)(lds + 4 * SHM_V);
    bool done = false;
    for (int j = 1; j + 1 < NT; j += 2) {
        SBAR(); qkt(pB0, pB1, K_lds + SHM_K, qr, r32, hi);
        sb_half(pA0, carry, (j - 1) < 4, K0(j - 1), tq, hi); pack_p(pA0, pA1, pa0, pa1, pa2, pa3); SBAR();
        { const int z = __all(carry == 0.0f); if (lane == 0) votes[wid] = (unsigned)z; }
        SLOAD(SO, K0(j + 1)); SBAR();
        pv_d0(o, vb0, pa0, pa1, pa2, pa3); sb_half(pB1, carry, j < 4, K0(j) + 32, tq, hi);
        __syncthreads();
        { unsigned a = 1u;
#pragma unroll
          for (int w = 0; w < 8; ++w) a &= votes[w];
          if (a) { done = true; break; } }
        SWAIT(); SWRITE(0, SE);
        __syncthreads();
        SBAR(); qkt(pA0, pA1, K_lds, qr, r32, hi);
        sb_half(pB0, carry, j < 4, K0(j), tq, hi); pack_p(pB0, pB1, pa0, pa1, pa2, pa3); SBAR();
        { const int z = __all(carry == 0.0f); if (lane == 0) votes[8 + wid] = (unsigned)z; }
        SLOAD(SE, K0(j + 2)); SBAR();
        pv_d0(o, vb0 + (int)SHM_V, pa0, pa1, pa2, pa3); sb_half(pA1, carry, (j + 1) < 4, K0(j + 1) + 32, tq, hi);
        __syncthreads();
        { unsigned a = 1u;
#pragma unroll
          for (int w = 0; w < 8; ++w) a &= votes[8 + w];
          if (a) { done = true; break; } }
        SWAIT(); SWRITE(1, SO);
        __syncthreads();
    }
    if (!done) {
        SBAR(); qkt(pB0, pB1, K_lds + SHM_K, qr, r32, hi);
        sb_half(pA0, carry, (NT - 2) < 4, K0(NT - 2), tq, hi); pack_p(pA0, pA1, pa0, pa1, pa2, pa3); SBAR();
        pv_d0(o, vb0, pa0, pa1, pa2, pa3); sb_half(pB1, carry, (NT - 1) < 4, K0(NT - 1) + 32, tq, hi);
        sb_half(pB0, carry, (NT - 1) < 4, K0(NT - 1), tq, hi); pack_p(pB0, pB1, pa0, pa1, pa2, pa3); SBAR();
        pv_d0(o, vb0 + (int)SHM_V, pa0, pa1, pa2, pa3);
    }
    bf16* Ow = Ob + (size_t)(q0 + wid * 32) * LD;
#pragma unroll
    for (int r = 0; r < 16; ++r) { const int orow = crow(r, hi);
#pragma unroll
        for (int d0 = 0; d0 < 4; ++d0) Ow[(size_t)orow * LD + d0 * 32 + r32] = (bf16)f2bf(o[d0][r]); }
#undef K0
#undef SLOAD
#undef SWRITE
#undef SWAIT
}
}

#define XB_TMO      128
#define XB_XCNT(j)  (256  + 64 * (j))
#define XB_XSUB(j)  (1280 + 64 * (j))
#define XB_XGEN(j)  (2304 + 64 * (j))
#define XB_TOP      3328
#define XB_TOPGEN   3392
#define XCD_BAR_WORDS 3456
#define XB_SPIN_CAP (1u << 18)

__device__ __forceinline__ unsigned xb_ld(unsigned* p)              { return __hip_atomic_load(p, __ATOMIC_RELAXED, __HIP_MEMORY_SCOPE_AGENT); }
__device__ __forceinline__ unsigned xb_add(unsigned* p, unsigned v) { return __hip_atomic_fetch_add(p, v, __ATOMIC_RELAXED, __HIP_MEMORY_SCOPE_AGENT); }
__device__ __forceinline__ unsigned xb_xcc_id() { return (unsigned)__builtin_amdgcn_s_getreg((3 << 11) | 20) & 0xFu; }
#define XB_SPIN(cond, bar) do { unsigned _sp = 0; while (cond) { __builtin_amdgcn_s_sleep(1); \
    if ((++_sp & 255u) == 0u) { if (xb_ld(&(bar)[XB_TMO])) break; if (_sp > XB_SPIN_CAP) { atomicAdd(&(bar)[XB_TMO], 1u); break; } } } } while (0)

struct XcdBarrier {
    unsigned* bar; unsigned x;
    volatile LAS unsigned* st;
};

__device__ __forceinline__ XcdBarrier xcd_barrier_post(unsigned* bar, volatile LAS unsigned* st, const bool TID0) {
    XcdBarrier b; b.bar = bar; b.x = xb_xcc_id(); b.st = st;
    if (TID0) (void)xb_add(&bar[XB_XCNT(b.x)], 1u);
    return b;
}
__device__ __forceinline__ void xcd_barrier_complete(unsigned* bar, unsigned x, unsigned& nloc, unsigned& nx) {
    const unsigned G = gridDim.x * gridDim.y * gridDim.z;
    unsigned sum, cnt, mine, sp = 0u;
    for (;;) {
        sum = 0u; cnt = 0u; mine = 0u;
#pragma unroll
        for (unsigned j = 0; j < 16; ++j) { const unsigned c = xb_ld(&bar[XB_XCNT(j)]); sum += c; cnt += (c > 0u) ? 1u : 0u; mine = (j == x) ? c : mine; }
        if (sum == G) break;
        __builtin_amdgcn_s_sleep(1);
        if ((++sp & 255u) == 0u) { if (xb_ld(&bar[XB_TMO])) break; if (sp > XB_SPIN_CAP) { atomicAdd(&bar[XB_TMO], 1u); break; } }
    }
    nloc = mine > 0u ? mine : 1u; nx = cnt > 0u ? cnt : 1u;
}

__device__ __forceinline__ void xcd_barrier(const XcdBarrier& b, const int wv0) {
    const bool TID0 = (opaque(TID()) == 0);
    asm volatile("s_waitcnt vmcnt(0)" ::: "memory");
    __syncthreads();
    if (TID0) {
        unsigned* bar = b.bar;
        __builtin_amdgcn_s_waitcnt(0);
        unsigned nloc = b.st[0], nx = b.st[1];
        if (nloc == 0u) { xcd_barrier_complete(bar, b.x, nloc, nx); b.st[0] = nloc; b.st[1] = nx; }
        const unsigned old = xb_add(&bar[XB_XSUB(b.x)], 1u);
        const unsigned gen = old / nloc;
        if (old + 1u == (gen + 1u) * nloc) {
            __builtin_amdgcn_fence(__ATOMIC_RELEASE, "agent");
            asm volatile("s_waitcnt vmcnt(0)" ::: "memory");
            const unsigned og = xb_add(&bar[XB_TOP], 1u);
            const unsigned tg = og / nx;
            if (og + 1u == (tg + 1u) * nx) xb_add(&bar[XB_TOPGEN], 1u);
            else XB_SPIN(xb_ld(&bar[XB_TOPGEN]) == tg, bar);
            __builtin_amdgcn_fence(__ATOMIC_ACQUIRE, "agent");
            xb_add(&bar[XB_XGEN(b.x)], 1u);
            asm volatile("s_waitcnt vmcnt(0)" ::: "memory");
        } else {
            XB_SPIN(xb_ld(&bar[XB_XGEN(b.x)]) == gen, bar);
            __builtin_amdgcn_fence(__ATOMIC_ACQUIRE, "agent");
            asm volatile("s_waitcnt vmcnt(0)" ::: "memory");
        }
    }
    __syncthreads();
}


struct Args { const float* in[20]; float* out; unsigned char* ws; };
struct Ptrs {
    unsigned base;
    __device__ __forceinline__ unsigned long long get(int k) const { unsigned a; asm volatile("v_mov_b32 %0, %1" : "=v"(a) : "s"(base)); const unsigned long long v = *(const LAS unsigned long long*)(a + 8u * (unsigned)k);
        const unsigned lo = __builtin_amdgcn_readfirstlane((unsigned)v), hi = __builtin_amdgcn_readfirstlane((unsigned)(v >> 32)); return ((unsigned long long)hi << 32) | lo; }
    __device__ __forceinline__ const float* in(int k) const { return (const float*)(const __attribute__((address_space(1))) float*)get(k); }
    __device__ __forceinline__ float* out() const { return (float*)(__attribute__((address_space(1))) float*)get(20); }
    __device__ __forceinline__ unsigned char* ws() const { return (unsigned char*)(__attribute__((address_space(1))) unsigned char*)get(21); }
};

__device__ __forceinline__ void transpose_item(const float* W, int ldw, int src_n0, int k0, bf16* WT, int K, int dst_n0, LAS float* scr, int lane) {
    float tv[32];
#pragma unroll
    for (int i = 0; i < 32; ++i) { const int kk = 2 * i + (lane >> 5); tv[i] = W[(size_t)(k0 + kk) * ldw + src_n0 + (lane & 31)]; }
#pragma unroll
    for (int i = 0; i < 32; ++i) { const int kk = 2 * i + (lane >> 5); scr[kk * 33 + (lane & 31)] = tv[i]; }
    LDS_WAIT(); asm volatile("" ::: "memory");
    const int c = lane & 7;
#pragma unroll
    for (int j = 0; j < 4; ++j) { const int n = (lane >> 3) + 8 * j; const LAS float* s = scr + (8 * c) * 33 + n;
        u32x4 o; o.x = pk2(s[0 * 33], s[1 * 33]); o.y = pk2(s[2 * 33], s[3 * 33]); o.z = pk2(s[4 * 33], s[5 * 33]); o.w = pk2(s[6 * 33], s[7 * 33]);
        *(u32x4*)(WT + (size_t)(dst_n0 + n) * K + k0 + 8 * c) = o; }
    LDS_WAIT(); asm volatile("" ::: "memory");
}
__device__ __forceinline__ void convert_weights(const Ptrs& A, int l, LAS unsigned char* lds, int gw, int NGW, int wave, int lane_) {
    const int lane = opaque(lane_);
    LAS float* scr = (LAS float*)(lds + wave * 16384);
    unsigned char* ws = A.ws();
    constexpr int I_IN = 32 * 416, I_BR = 16 * 64, I_O = 32 * 64, I_GU = 32 * 352, I_DN = 88 * 64, I_MK = 32 * 64;
    const int total = I_IN + 3 * I_BR + I_O + I_GU + I_DN + (l == 0 ? 2 * I_MK : 0);
    for (int it = gw; it < total; it += NGW) {
        int r = it;
        if (r < I_IN) { const int kb = r / 416, nb = r % 416, dn = 32 * nb; transpose_item(A.in(3) + (size_t)l * DM * INW, INW, dn + (dn >= 3072 ? 16 : 0), 64 * kb, (bf16*)(ws + WS_WIN), DM, dn, scr, lane); continue; } r -= I_IN;
        if (r < 3 * I_BR) { const int br = r / I_BR, q = r % I_BR, kb = q / 64, nb = q % 64; const float* W = (br == 0 ? A.in(7) : (br == 1 ? A.in(10) : A.in(15))) + (size_t)l * 1024 * DM;
            transpose_item(W, DM, 32 * nb, 64 * kb, (bf16*)(ws + WS_WBR), 1024, br * 2048 + 32 * nb, scr, lane); continue; } r -= 3 * I_BR;
        if (r < I_O) { const int kb = r / 64, nb = r % 64; transpose_item(A.in(16) + (size_t)l * DM * DM, DM, 32 * nb, 64 * kb, (bf16*)(ws + WS_WO), DM, 32 * nb, scr, lane); continue; } r -= I_O;
        if (r < I_GU) { const int kb = r / 352, nb = r % 352, dn = 32 * nb, p = dn >> 8, half = (dn >> 7) & 1, q = dn & 127;
            transpose_item(A.in(18) + (size_t)l * DM * 2 * DFF, 2 * DFF, half * DFF + 128 * p + q, 64 * kb, (bf16*)(ws + WS_WGU), DM, dn, scr, lane); continue; } r -= I_GU;
        if (r < I_DN) { const int kb = r / 64, nb = r % 64; transpose_item(A.in(19) + (size_t)l * DFF * DM, DM, 32 * nb, 64 * kb, (bf16*)(ws + WS_WDN), DFF, 32 * nb, scr, lane); continue; } r -= I_DN;
        { const int l2 = r / I_MK, q = r % I_MK, kb = q / 64, nb = q % 64; transpose_item(A.in(12) + (size_t)l2 * DM * DM, DM, 32 * nb, 64 * kb, (bf16*)(ws + WS_WMK) + (size_t)l2 * DM * DM, DM, 32 * nb, scr, lane); }
    }
}
template <bool GA, bool XBF = false>
__device__ __forceinline__ void norm_rows(const float* X, const float* gain, bf16* H, float* GA1, const LAS float* waT, int nrows, int gw, int NGW, int lane_) {
    const int lane = opaque(lane_);
    for (int m = gw; m < nrows; m += NGW) {
        f32x4 v[8]; float s = 0.f;
        if constexpr (XBF) { const u32x2* xb = (const u32x2*)((const bf16*)X + (size_t)m * DM) + lane;
#pragma unroll
            for (int j = 0; j < 8; ++j) { const u32x2 w = xb[64 * j]; v[j] = (f32x4){bflo(w.x), bfhi(w.x), bflo(w.y), bfhi(w.y)}; }
        } else { const f32x4* xr = (const f32x4*)(X + (size_t)m * DM) + lane;
#pragma unroll
            for (int j = 0; j < 8; ++j) v[j] = xr[64 * j]; }
#pragma unroll
        for (int j = 0; j < 8; ++j) s += (v[j].x * v[j].x + v[j].y * v[j].y) + (v[j].z * v[j].z + v[j].w * v[j].w);
        const float rinv = 1.0f / sqrtf(wave_sum(s) * (1.0f / DM) + EPS);
        unsigned long long* o8 = (unsigned long long*)(H + (size_t)m * DM) + lane;
#pragma unroll
        for (int j = 0; j < 8; ++j) { const f32x4 g = ((const f32x4*)gain)[lane + 64 * j]; v[j] = v[j] * rinv * g;
            o8[64 * j] = (unsigned long long)pk2(v[j].x, v[j].y) | ((unsigned long long)pk2(v[j].z, v[j].w) << 32); }
        if constexpr (GA) {
            float mine = 0.f;
#pragma unroll 1
            for (int r = 0; r < 16; ++r) { float a = 0.f;
#pragma unroll
                for (int j = 0; j < 8; ++j) { const f32x4 w = *(const LAS f32x4*)(waT + r * DM + 256 * j + 4 * lane); a += (v[j].x * w.x + v[j].y * w.y) + (v[j].z * w.z + v[j].w * w.w); }
                a = wave_sum(a); mine = (lane == r) ? a : mine; }
            if (lane < 16) GA1[(size_t)m * 16 + lane] = mine;
        }
    }
}
__device__ __forceinline__ void qknorm_one(const u32x4 w0, const u32x4 w1, bf16* base, const float* gain, const int which, const float fac) {
    float x[16];
    x[0] = bflo(w0.x); x[1] = bfhi(w0.x); x[2] = bflo(w0.y); x[3] = bfhi(w0.y); x[4] = bflo(w0.z); x[5] = bfhi(w0.z); x[6] = bflo(w0.w); x[7] = bfhi(w0.w);
    x[8] = bflo(w1.x); x[9] = bfhi(w1.x); x[10] = bflo(w1.y); x[11] = bfhi(w1.y); x[12] = bflo(w1.z); x[13] = bfhi(w1.z); x[14] = bflo(w1.w); x[15] = bfhi(w1.w);
    float s = 0.f;
#pragma unroll
    for (int e = 0; e < 16; ++e) s += x[e] * x[e];
    s = (which == 2) ? red16(s) : red8(s);
    const float rinv = fac / sqrtf(s * (which == 2 ? (1.0f / 256.0f) : (1.0f / 128.0f)) + EPS);
#pragma unroll
    for (int e = 0; e < 16; ++e) x[e] = x[e] * rinv * gain[e];
    u32x4 o0, o1; o0.x = pk2(x[0], x[1]); o0.y = pk2(x[2], x[3]); o0.z = pk2(x[4], x[5]); o0.w = pk2(x[6], x[7]);
    o1.x = pk2(x[8], x[9]); o1.y = pk2(x[10], x[11]); o1.z = pk2(x[12], x[13]); o1.w = pk2(x[14], x[15]);
    *(u32x4*)base = o0; *(u32x4*)(base + 8) = o1;
}
__device__ __forceinline__ void qknorm_rows(const Ptrs& A, int l, int gw, int NGW, int lane_) {
    const int lane = opaque(lane_);
    unsigned char* ws = A.ws();
    for (int id = gw; id < 3 * T; id += 2 * NGW) {
        const int which = id / T, row = id - which * T; const int id2 = id + NGW; const bool two = (id2 < 3 * T) && (id2 / T == which);
        bf16* base = (bf16*)(ws + (which == 0 ? WS_SQ : (which == 1 ? WS_SK : WS_MQ))) + (size_t)row * 1024 + 16 * lane;
        bf16* base2 = base + (size_t)NGW * 1024;
        const int hw = (which == 2) ? 16 : 8;
        const float* gain = (which == 0 ? A.in(8) : (which == 1 ? A.in(9) : A.in(13))) + (size_t)l * (which == 2 ? 256 : 128) + 16 * (lane & (hw - 1));
        const float fac = (which == 0) ? (0.08838834764831845f * LOG2E) : ((which == 2) ? (0.0625f * LOG2E) : 1.0f);
        const u32x4 w0 = *(const u32x4*)base, w1 = *(const u32x4*)(base + 8);
        u32x4 v0 = w0, v1 = w1;
        if (two) { v0 = *(const u32x4*)base2; v1 = *(const u32x4*)(base2 + 8); }
        qknorm_one(w0, w1, base, gain, which, fac);
        if (two) qknorm_one(v0, v1, base2, gain, which, fac);
        else if (id2 < 3 * T) {
            const int which2 = id2 / T, row2 = id2 - which2 * T;
            bf16* b2 = (bf16*)(ws + (which2 == 0 ? WS_SQ : (which2 == 1 ? WS_SK : WS_MQ))) + (size_t)row2 * 1024 + 16 * lane;
            const int hw2 = (which2 == 2) ? 16 : 8;
            const float* gain2 = (which2 == 0 ? A.in(8) : (which2 == 1 ? A.in(9) : A.in(13))) + (size_t)l * (which2 == 2 ? 256 : 128) + 16 * (lane & (hw2 - 1));
            const float fac2 = (which2 == 0) ? (0.08838834764831845f * LOG2E) : ((which2 == 2) ? (0.0625f * LOG2E) : 1.0f);
            const u32x4 y0 = *(const u32x4*)b2, y1 = *(const u32x4*)(b2 + 8);
            qknorm_one(y0, y1, b2, gain2, which2, fac2);
        }
    }
}
__device__ __forceinline__ void memkv_naive(const Ptrs& A, LAS unsigned char* lds, int wave, int lane_, const int wv0) {
    unsigned char* ws = A.ws(); const int tid = opaque(TID()), lane = tid & 63, r32 = lane & 31, hi = lane >> 5;
    LAS float* red = (LAS float*)lds;
    for (int id = blockIdx.x; id < 1024; id += gridDim.x) {
        const int l2 = id >> 9, rem = id & 511, mt = rem >> 6, nt = rem & 63;
        const bf16* hm = (const bf16*)(ws + WS_HM) + ((size_t)l2 * 256 + 32 * mt + r32) * DM + 256 * wave + 8 * hi;
        const bf16* wk = (const bf16*)(ws + WS_WMK) + ((size_t)l2 * DM + 32 * nt + r32) * DM + 256 * wave + 8 * hi;
        f32x16 acc = {};
#pragma unroll 4
        for (int s = 0; s < 16; ++s) { const bf16x8 a = *(const bf16x8*)(hm + 16 * s), b = *(const bf16x8*)(wk + 16 * s); acc = __builtin_amdgcn_mfma_f32_32x32x16_bf16(a, b, acc, 0, 0, 0); }
#pragma unroll
        for (int r = 0; r < 16; ++r) red[(wave * 16 + r) * 64 + lane] = acc[r];
        __syncthreads();
#pragma unroll
        for (int i = 0; i < 2; ++i) { const int e = tid + 512 * i, r = e >> 6, ln = e & 63; float s = 0.f;
#pragma unroll
            for (int w = 0; w < 8; ++w) s += red[(w * 16 + r) * 64 + ln];
            ((float*)(ws + WS_MEMKV))[((size_t)l2 * 256 + 32 * mt + crow(r, ln >> 5)) * DM + 32 * nt + (ln & 31)] = s; }
        __syncthreads();
    }
}
__device__ __forceinline__ void memkv_post(const Ptrs& A, int gw, int NGW, int lane_) {
    const int lane = opaque(lane_);
    unsigned char* ws = A.ws(); const float* kv = (const float*)(ws + WS_MEMKV);
    for (int id = gw; id < 2048; id += NGW) {
        const int l2 = id >> 10, hd = (id >> 8) & 3, m = id & 255;
        const f32x4 x = *(const f32x4*)(kv + ((size_t)l2 * 256 + m) * DM + hd * 256 + 4 * lane);
        const float s = wave_sum((x.x * x.x + x.y * x.y) + (x.z * x.z + x.w * x.w));
        const float rinv = 1.0f / sqrtf(s * (1.0f / 256.0f) + EPS);
        const f32x4 g = *(const f32x4*)(A.in(14) + (size_t)l2 * 256 + 4 * lane);
        *(unsigned long long*)((bf16*)(ws + WS_KN) + (((size_t)l2 * 4 + hd) * 256 + m) * 256 + 4 * lane) =
            (unsigned long long)pk2(x.x * rinv * g.x, x.y * rinv * g.y) | ((unsigned long long)pk2(x.z * rinv * g.z, x.w * rinv * g.w) << 32);
    }
    const int gt = gw * 64 + lane, NGT = NGW * 64;
    for (int id = gt; id < 65536; id += NGT) {
        const int l2 = id >> 15, row = (id >> 5) & 1023, mg = id & 31;
        const float* src = kv + ((size_t)l2 * 256 + 8 * mg) * DM + 1024 + row;
        u32x4 o; o.x = pk2(src[0], src[DM]); o.y = pk2(src[2 * DM], src[3 * DM]); o.z = pk2(src[4 * DM], src[5 * DM]); o.w = pk2(src[6 * DM], src[7 * DM]);
        *(u32x4*)((bf16*)(ws + WS_VT) + ((size_t)l2 * 1024 + row) * 256 + 8 * mg) = o;
    }
}
constexpr int BLS = 132;
__device__ __forceinline__ void gla_cumdecay(const Ptrs& A, int l, int n, int hd, LAS float* bl, const int wv0) {
    const int tid = opaque(TID()), d = tid & 127, tq = __builtin_amdgcn_readfirstlane(tid >> 7);
    const float* wa2 = A.in(4) + (size_t)l * 16 * 512 + hd * 128 + d;
    float w[16];
#pragma unroll
    for (int r = 0; r < 16; ++r) w[r] = wa2[r * 512];
    const float bias = A.in(5)[(size_t)l * 512 + hd * 128 + d];
    LAS float* gal = bl + 29184;
    *(LAS f32x2*)(gal + 2 * tid) = *(const f32x2*)((const float*)(A.ws() + WS_GA1) + (size_t)n * 64 * 16 + 2 * tid);
    __syncthreads();
    const LAS float* ga = gal + 16 * tq * 16;
    float run = 0.f;
    for (int tt = 0; tt < 16; ++tt) {
        float pre = bias;
        const f32x4 g0 = *(const LAS f32x4*)(ga + tt * 16), g1 = *(const LAS f32x4*)(ga + tt * 16 + 4), g2 = *(const LAS f32x4*)(ga + tt * 16 + 8), g3 = *(const LAS f32x4*)(ga + tt * 16 + 12);
        pre += (g0.x * w[0] + g0.y * w[1]) + (g0.z * w[2] + g0.w * w[3]); pre += (g1.x * w[4] + g1.y * w[5]) + (g1.z * w[6] + g1.w * w[7]);
        pre += (g2.x * w[8] + g2.y * w[9]) + (g2.z * w[10] + g2.w * w[11]); pre += (g3.x * w[12] + g3.y * w[13]) + (g3.z * w[14] + g3.w * w[15]);
        const float la = (fminf(pre, 0.f) - __logf(1.0f + __expf(-fabsf(pre)))) * (1.0f / 16.0f);
        run += la; bl[(16 * tq + tt) * BLS + d] = run;
    }
    __syncthreads();
    float add = 0.f;
#pragma unroll
    for (int q = 0; q < 3; ++q) if (q < tq) add += bl[(16 * q + 15) * BLS + d];
    __syncthreads();
    if (tq > 0) for (int tt = 0; tt < 16; ++tt) bl[(16 * tq + tt) * BLS + d] += add;
    __syncthreads();
}
__device__ __forceinline__ void unpack8(const u32x4 w, float* x) { x[0] = bflo(w.x); x[1] = bfhi(w.x); x[2] = bflo(w.y); x[3] = bfhi(w.y); x[4] = bflo(w.z); x[5] = bfhi(w.z); x[6] = bflo(w.w); x[7] = bfhi(w.w); }
__device__ __forceinline__ void gla_load_vt(const bf16* GVc, LAS bf16* VTl, int wave, int lane) {
    u32x4 vv[4];
#pragma unroll
    for (int i = 0; i < 4; ++i) vv[i] = *(const u32x4*)(GVc + (size_t)lane * 1024 + (wave + 8 * i) * 8);
#pragma unroll
    for (int i = 0; i < 4; ++i) { const int v0 = (wave + 8 * i) * 8; LAS bf16* p = VTl + v0 * 72 + lane;
        p[0] = (bf16)(vv[i].x & 0xffff); p[72] = (bf16)(vv[i].x >> 16); p[144] = (bf16)(vv[i].y & 0xffff); p[216] = (bf16)(vv[i].y >> 16);
        p[288] = (bf16)(vv[i].z & 0xffff); p[360] = (bf16)(vv[i].z >> 16); p[432] = (bf16)(vv[i].w & 0xffff); p[504] = (bf16)(vv[i].w >> 16); }
}
__device__ __forceinline__ void gla_state(const Ptrs& A, int l, LAS unsigned char* lds, int c, int G, int wave, int lane_, const int wv0) {
    unsigned char* ws = A.ws(); const int tid = opaque(TID()), lane = tid & 63, r32 = lane & 31, hi = lane >> 5;
    LAS float* bl = (LAS float*)lds; LAS bf16* KdT = (LAS bf16*)(lds + 33792); LAS bf16* VTl = (LAS bf16*)(lds + 33792 + 128 * 72 * 2);
    const bf16* GK = (const bf16*)(ws + WS_GK); const bf16* GV = (const bf16*)(ws + WS_GV); bf16* US = (bf16*)(ws + WS_H);
    for (int it = c; it < 1024; it += G) {
        const int n = it >> 2, hd = it & 3, t0 = n * 64;
        u32x4 kk[2];
#pragma unroll
        for (int i = 0; i < 2; ++i) kk[i] = *(const u32x4*)(GK + (size_t)(t0 + lane) * 512 + hd * 128 + (wave + 8 * i) * 8);
        gla_cumdecay(A, l, n, hd, bl, wv0);
        gla_load_vt(GV + (size_t)t0 * 1024 + hd * 256, VTl, wave, lane);
#pragma unroll
        for (int i = 0; i < 2; ++i) { const int d0 = (wave + 8 * i) * 8; float x[8]; unpack8(kk[i], x);
            const f32x4 b0 = *(const LAS f32x4*)(bl + lane * BLS + d0), b1 = *(const LAS f32x4*)(bl + lane * BLS + d0 + 4);
            const f32x4 e0 = *(const LAS f32x4*)(bl + 63 * BLS + d0), e1 = *(const LAS f32x4*)(bl + 63 * BLS + d0 + 4);
            LAS bf16* p = KdT + d0 * 72 + lane;
            p[0] = (bf16)f2bf(x[0] * __expf(e0.x - b0.x)); p[72] = (bf16)f2bf(x[1] * __expf(e0.y - b0.y)); p[144] = (bf16)f2bf(x[2] * __expf(e0.z - b0.z)); p[216] = (bf16)f2bf(x[3] * __expf(e0.w - b0.w));
            p[288] = (bf16)f2bf(x[4] * __expf(e1.x - b1.x)); p[360] = (bf16)f2bf(x[5] * __expf(e1.y - b1.y)); p[432] = (bf16)f2bf(x[6] * __expf(e1.z - b1.z)); p[504] = (bf16)f2bf(x[7] * __expf(e1.w - b1.w)); }
        if (tid < 128) ((float*)(ws + WS_DEC))[(size_t)it * 128 + tid] = __expf(bl[63 * BLS + tid]);
        __syncthreads();
        bf16x8 af[4];
#pragma unroll
        for (int ks = 0; ks < 4; ++ks) af[ks] = *(const LAS bf16x8*)(VTl + (32 * wave + r32) * 72 + 16 * ks + 8 * hi);
#pragma unroll
        for (int j = 0; j < 4; ++j) { f32x16 acc = {};
#pragma unroll
            for (int ks = 0; ks < 4; ++ks) { const bf16x8 b = *(const LAS bf16x8*)(KdT + (32 * j + r32) * 72 + 16 * ks + 8 * hi); acc = __builtin_amdgcn_mfma_f32_32x32x16_bf16(af[ks], b, acc, 0, 0, 0); }
#pragma unroll
            for (int r = 0; r < 16; ++r) US[((size_t)it * 256 + 32 * wave + crow(r, hi)) * 128 + 32 * j + r32] = (bf16)f2bf(acc[r]); }
        __syncthreads();
    }
}
__device__ __forceinline__ void gla_scan(const Ptrs& A, const int wv0) {
    const int tid = opaque(TID());
    unsigned char* ws = A.ws();
    for (int g = blockIdx.x * 512 + tid; g < 131072; g += gridDim.x * 512) {
        const int hd = g >> 15, v = (g >> 7) & 255, d = g & 127;
        bf16* us = (bf16*)(ws + WS_H) + ((size_t)hd * 256 + v) * 128 + d;
        const float* dec = (const float*)(ws + WS_DEC) + hd * 128 + d;
        float st = 0.f;
        for (int n0 = 0; n0 < 256; n0 += 64) {
            bf16 u[64]; float dc[64];
#pragma unroll
            for (int i = 0; i < 64; ++i) { u[i] = us[(size_t)(n0 + i) * 131072]; dc[i] = dec[(size_t)(n0 + i) * 512]; }
#pragma unroll
            for (int i = 0; i < 64; ++i) { us[(size_t)(n0 + i) * 131072] = (bf16)f2bf(st); st = st * dc[i] + bf2f(u[i]); }
        }
    }
}
__device__ __forceinline__ void gla_out(const Ptrs& A, int l, LAS unsigned char* lds, int c, int G, int wave, int lane_, const int wv0) {
    unsigned char* ws = A.ws(); const int tid = opaque(TID()), lane = tid & 63, r32 = lane & 31, hi = lane >> 5;
    LAS float* bl = (LAS float*)lds; LAS bf16* QE = (LAS bf16*)(lds + 33792); LAS bf16* KE = (LAS bf16*)(lds + 51200); LAS bf16* VTl = (LAS bf16*)(lds + 68608);
    LAS bf16* SM = (LAS bf16*)(lds + 105472); LAS float* red = (LAS float*)(lds + 114688);
    const bf16* GQ = (const bf16*)(ws + WS_GQ); const bf16* GK = (const bf16*)(ws + WS_GK); const bf16* GV = (const bf16*)(ws + WS_GV); const bf16* GR = (const bf16*)(ws + WS_GR);
    const bf16* US = (const bf16*)(ws + WS_H); bf16* AG = (bf16*)(ws + WS_ABR);
    const float* gout = A.in(6) + (size_t)l * 256;
    for (int it = c; it < 1024; it += G) {
        const int n = it >> 2, hd = it & 3, t0 = n * 64;
        u32x4 qq[2], kk[2];
#pragma unroll
        for (int i = 0; i < 2; ++i) { qq[i] = *(const u32x4*)(GQ + (size_t)(t0 + lane) * 512 + hd * 128 + (wave + 8 * i) * 8); kk[i] = *(const u32x4*)(GK + (size_t)(t0 + lane) * 512 + hd * 128 + (wave + 8 * i) * 8); }
        gla_cumdecay(A, l, n, hd, bl, wv0);
        gla_load_vt(GV + (size_t)t0 * 1024 + hd * 256, VTl, wave, lane);
#pragma unroll
        for (int i = 0; i < 2; ++i) { const int d0 = (wave + 8 * i) * 8; float xq[8], xk[8]; unpack8(qq[i], xq); unpack8(kk[i], xk);
            const f32x4 b0 = *(const LAS f32x4*)(bl + lane * BLS + d0), b1 = *(const LAS f32x4*)(bl + lane * BLS + d0 + 4);
            float eb[8]; eb[0] = __expf(b0.x); eb[1] = __expf(b0.y); eb[2] = __expf(b0.z); eb[3] = __expf(b0.w); eb[4] = __expf(b1.x); eb[5] = __expf(b1.y); eb[6] = __expf(b1.z); eb[7] = __expf(b1.w);
            u32x4 oq, ok;
            oq.x = pk2(xq[0] * 0.08838834764831845f * eb[0], xq[1] * 0.08838834764831845f * eb[1]); oq.y = pk2(xq[2] * 0.08838834764831845f * eb[2], xq[3] * 0.08838834764831845f * eb[3]);
            oq.z = pk2(xq[4] * 0.08838834764831845f * eb[4], xq[5] * 0.08838834764831845f * eb[5]); oq.w = pk2(xq[6] * 0.08838834764831845f * eb[6], xq[7] * 0.08838834764831845f * eb[7]);
            ok.x = pk2(xk[0] * __builtin_amdgcn_rcpf(eb[0]), xk[1] * __builtin_amdgcn_rcpf(eb[1])); ok.y = pk2(xk[2] * __builtin_amdgcn_rcpf(eb[2]), xk[3] * __builtin_amdgcn_rcpf(eb[3]));
            ok.z = pk2(xk[4] * __builtin_amdgcn_rcpf(eb[4]), xk[5] * __builtin_amdgcn_rcpf(eb[5])); ok.w = pk2(xk[6] * __builtin_amdgcn_rcpf(eb[6]), xk[7] * __builtin_amdgcn_rcpf(eb[7]));
            *(LAS u32x4*)(QE + lane * 136 + d0) = oq; *(LAS u32x4*)(KE + lane * 136 + d0) = ok; }
        __syncthreads();
        if (wave < 4) { const int ti = wave >> 1, tj = wave & 1; f32x16 acc = {};
            if (tj <= ti) {
#pragma unroll
                for (int ks = 0; ks < 8; ++ks) { const bf16x8 a = *(const LAS bf16x8*)(QE + (32 * ti + r32) * 136 + 16 * ks + 8 * hi), b = *(const LAS bf16x8*)(KE + (32 * tj + r32) * 136 + 16 * ks + 8 * hi);
                    acc = __builtin_amdgcn_mfma_f32_32x32x16_bf16(a, b, acc, 0, 0, 0); } }
#pragma unroll
            for (int r = 0; r < 16; ++r) { const int t = 32 * ti + crow(r, hi), sx = 32 * tj + r32; SM[t * 72 + sx] = (bf16)f2bf(sx <= t ? acc[r] : 0.f); } }
        __syncthreads();
        const int ti = wave & 1, vq = wave >> 1;
        f32x16 o0 = {}, o1 = {};
        {
            const bf16* sb0 = US + ((size_t)it * 256 + 64 * vq + r32) * 128 + 8 * hi; const bf16* sb1 = sb0 + 32 * 128;
#pragma unroll
            for (int ks = 0; ks < 8; ++ks) { const bf16x8 a = *(const LAS bf16x8*)(QE + (32 * ti + r32) * 136 + 16 * ks + 8 * hi);
                const bf16x8 b0 = *(const bf16x8*)(sb0 + 16 * ks), b1 = *(const bf16x8*)(sb1 + 16 * ks);
                o0 = __builtin_amdgcn_mfma_f32_32x32x16_bf16(a, b0, o0, 0, 0, 0); o1 = __builtin_amdgcn_mfma_f32_32x32x16_bf16(a, b1, o1, 0, 0, 0); }
#pragma unroll
            for (int ks = 0; ks < 4; ++ks) { const bf16x8 a = *(const LAS bf16x8*)(SM + (32 * ti + r32) * 72 + 16 * ks + 8 * hi);
                const bf16x8 b0 = *(const LAS bf16x8*)(VTl + (64 * vq + r32) * 72 + 16 * ks + 8 * hi), b1 = *(const LAS bf16x8*)(VTl + (64 * vq + 32 + r32) * 72 + 16 * ks + 8 * hi);
                o0 = __builtin_amdgcn_mfma_f32_32x32x16_bf16(a, b0, o0, 0, 0, 0); o1 = __builtin_amdgcn_mfma_f32_32x32x16_bf16(a, b1, o1, 0, 0, 0); }
        }
#pragma unroll
        for (int r = 0; r < 16; ++r) { float p = o0[r] * o0[r] + o1[r] * o1[r];
            p = red32(p);
            if (r32 == 0) red[vq * 64 + 32 * ti + crow(r, hi)] = p; }
        __syncthreads();
        const float g0 = gout[64 * vq + r32], g1 = gout[64 * vq + 32 + r32];
#pragma unroll
        for (int r = 0; r < 16; ++r) { const int t = 32 * ti + crow(r, hi);
            const float tot = (red[t] + red[64 + t]) + (red[128 + t] + red[192 + t]); const float rinv = 1.0f / sqrtf(tot * (1.0f / 256.0f) + EPS);
            const size_t off = (size_t)(t0 + t) * 1024 + hd * 256 + 64 * vq + r32;
            const float r0 = bf2f(GR[off]), r1 = bf2f(GR[off + 32]);
            AG[off] = (bf16)f2bf(o0[r] * rinv * g0 * r0 * pg8::sigmoid_f(r0)); AG[off + 32] = (bf16)f2bf(o1[r] * rinv * g1 * r1 * pg8::sigmoid_f(r1)); }
        __syncthreads();
    }
}

#ifndef PHASE_MASK
#define PHASE_MASK 0x7ff
#endif
#define PH(k) (((PHASE_MASK) >> (k)) & 1)
#ifndef DUP_GEMM
#define DUP_GEMM 0
#endif
#ifndef DUP_SYNC
#define DUP_SYNC 0
#endif
#ifndef DUP_ATTN
#define DUP_ATTN 0
#endif
#ifndef DUP_P5
#define DUP_P5 0
#endif
#define GBAR() do { XcdBarrier xb_; xb_.bar = (unsigned*)(A.ws() + WS_CTL); xb_.x = xb_xcc_id(); { unsigned a_; asm volatile("v_mov_b32 %0, %1" : "=v"(a_) : "s"(A.base + 192u)); xb_.st = (volatile LAS unsigned*)a_; } xcd_barrier(xb_, wv0); } while (0)
template <int l>
__device__ __forceinline__ void layer_body(const Ptrs& A, LAS unsigned char* lds, unsigned char* lds_raw, const int wv0) {
    unsigned char* ws; int tid, lane, wave, G, c, gw, NGW;
#define FRESH() do { ws = opaque_p(A.ws()); tid = opaque(TID()); lane = tid & 63; wave = __builtin_amdgcn_readfirstlane(tid >> 6); G = opaque_s(gridDim.x); c = opaque_s(blockIdx.x); gw = c * 8 + wave; NGW = G * 8; } while (0)


        FRESH();
        if (PH(1)) {
            convert_weights(A, l, lds, gw, NGW, wave, lane);
            __syncthreads();
            LAS float* waT = (LAS float*)lds;
            const float* win = A.in(3) + (size_t)l * DM * INW + 3072;
            for (int idx = tid; idx < 16 * DM; idx += 512) { const int k = idx >> 4, r = idx & 15; waT[r * DM + k] = win[(size_t)k * INW + r]; }
            __syncthreads();
            if constexpr (l == 0) norm_rows<true, false>(A.in(0), A.in(2) + (size_t)l * DM, (bf16*)(ws + WS_H), (float*)(ws + WS_GA1), waT, T, gw, NGW, lane);
            else norm_rows<true, true>((const float*)(ws + WS_X), A.in(2) + (size_t)l * DM, (bf16*)(ws + WS_H), (float*)(ws + WS_GA1), waT, T, gw, NGW, lane);
            if (l == 0) {
                norm_rows<false>(A.in(1), A.in(11), (bf16*)(ws + WS_HM), nullptr, waT, NMEM, gw, NGW, lane);
                norm_rows<false>(A.in(1), A.in(11) + DM, (bf16*)(ws + WS_HM) + (size_t)NMEM * DM, nullptr, waT, NMEM, gw, NGW, lane);
            }
            __syncthreads();
        }
        if constexpr (l == 0) cg::this_grid().sync(); else GBAR();
        if (DUP_SYNC) { GBAR(); GBAR(); }
        FRESH();
        if (PH(2)) {
            pg8::Gemm g{DM, DM, DM}; pg8::SchedGrid S; S.to.init(T / 256, NP / 256); S.G = G; S.c = c; S.A = (const char*)(ws + WS_H); S.B = (const char*)(ws + WS_WIN); S.ta = (size_t)256 * DM * 2; S.tb = (size_t)256 * DM * 2;
            pg8::EpiProj E{ws};
#pragma unroll 1
            for (int rep = 0; rep < 1 + DUP_GEMM; ++rep) { pg8::gemm_phase<pg8::EpiProj, pg8::SchedGrid, true, true>(lds, g, S, E, wv0); __syncthreads(); }
        }
        GBAR();
        if (DUP_SYNC) { GBAR(); GBAR(); }
        FRESH();
        if (PH(3)) {
            if (l == 0) memkv_naive(A, lds, wave, lane, wv0);
            qknorm_rows(A, l, gw, NGW, lane);
            __syncthreads();
            gla_state(A, l, lds, c, G, wave, lane, wv0);
        }
        GBAR();
        if (DUP_SYNC) { GBAR(); GBAR(); }
        FRESH();
        if (PH(4)) {
            if (l == 0) memkv_post(A, gw, NGW, lane);
            for (int u = c; u < 256 * (1 + DUP_ATTN); u += G) {
                const int head = (u & 255) >> 5, p = u & 31;
                const bf16* Q = (const bf16*)(ws + WS_SQ) + head * 128; const bf16* Kp = (const bf16*)(ws + WS_SK) + head * 128; const bf16* V = (const bf16*)(ws + WS_SV) + head * 128;
                bf16* O = (bf16*)(ws + WS_ABR) + (size_t)T * 1024 + head * 128;
#pragma unroll 1
                for (int rep = 0; rep < 2; ++rep) sba::sb_unit(Q, Kp, V, O, (rep ? p : 63 - p) * 256, (char*)lds_raw, wv0);
            }
            __syncthreads();
            gla_scan(A, wv0);
        }
        GBAR();
        if (DUP_SYNC) { GBAR(); GBAR(); }
        FRESH();
        if (PH(5)) {
#ifndef NO_MEMATT
            for (int u = c; u < 256; u += G) {
                const int pm = u >> 2, hd = u & 3;
                { pg8::Gemm g{256, 1024, 256}; pg8::SchedOne S; S.one.pm = pm; S.one.pn = hd; S.one.aux = 0;
                  S.one.a = (const char*)((const bf16*)(ws + WS_MQ) + (size_t)pm * 256 * 1024 + hd * 256); S.one.b = (const char*)((const bf16*)(ws + WS_KN) + ((size_t)l * 4 + hd) * 256 * 256);
                  pg8::EpiSoftmax E{(bf16*)(ws + WS_SQ)};
                  pg8::gemm_phase<pg8::EpiSoftmax, pg8::SchedOne, false, true>(lds, g, S, E, wv0); }
                asm volatile("s_waitcnt vmcnt(0)" ::: "memory"); __syncthreads();
                { pg8::Gemm g{256, 1024, 256}; pg8::SchedOne S; S.one.pm = pm; S.one.pn = hd; S.one.aux = 0;
                  S.one.a = (const char*)((const bf16*)(ws + WS_SQ) + (size_t)pm * 256 * 1024 + hd * 256); S.one.b = (const char*)((const bf16*)(ws + WS_VT) + ((size_t)l * 1024 + hd * 256) * 256);
                  pg8::EpiBf16 E{(bf16*)(ws + WS_ABR) + (size_t)2 * T * 1024, 1024};
                  pg8::gemm_phase<pg8::EpiBf16, pg8::SchedOne, false, true>(lds, g, S, E, wv0); }
                __syncthreads();
            }
#endif
#ifndef NO_GLAOUT
            gla_out(A, l, lds, c, G, wave, lane, wv0);
#endif
        }
        GBAR();
        if (DUP_SYNC) { GBAR(); GBAR(); }
        FRESH();
        if (PH(6)) {
            pg8::Gemm g{1024, 1024, 1024}; pg8::SchedBranch S; S.to.init(T / 256, DM / 256); S.G = G; S.c = c; S.A = (const char*)(ws + WS_ABR); S.B = (const char*)(ws + WS_WBR);
            pg8::EpiMerge E{(const unsigned char*)(ws + WS_GATES), (bf16*)(ws + WS_GV)};
#pragma unroll 1
            for (int rep = 0; rep < 1 + DUP_GEMM; ++rep) { pg8::gemm_phase<pg8::EpiMerge, pg8::SchedBranch, true, true>(lds, g, S, E, wv0); __syncthreads(); }
        }
        GBAR();
        if (DUP_SYNC) { GBAR(); GBAR(); }
        FRESH();
        if (PH(7)) {
            pg8::Gemm g{DM, DM, DM}; pg8::SchedGrid S; S.to.init(T / 256, DM / 256); S.G = G; S.c = c; S.A = (const char*)(ws + WS_GV); S.B = (const char*)(ws + WS_WO); S.ta = (size_t)256 * DM * 2; S.tb = (size_t)256 * DM * 2;
            if constexpr (l == 0) { pg8::EpiRes<false, true> E{(const void*)A.in(0), (void*)(ws + WS_X)}; pg8::gemm_phase<pg8::EpiRes<false, true>, pg8::SchedGrid, true, true>(lds, g, S, E, wv0); }
            else { pg8::EpiRes<true, true> E{(const void*)(ws + WS_X), (void*)(ws + WS_X)}; pg8::gemm_phase<pg8::EpiRes<true, true>, pg8::SchedGrid, true, true>(lds, g, S, E, wv0); }
        }
        GBAR();
        if (DUP_SYNC) { GBAR(); GBAR(); }
        FRESH();
        if (PH(8)) norm_rows<false, true>((const float*)(ws + WS_X), A.in(17) + (size_t)l * DM, (bf16*)(ws + WS_H), nullptr, (const LAS float*)lds, T, gw, NGW, lane);
        GBAR();
        if (DUP_SYNC) { GBAR(); GBAR(); }
        FRESH();
        if (PH(9)) {
            pg8::Gemm g{DM, DM, DM}; pg8::SchedGrid S; S.to.init(T / 256, 2 * DFF / 256); S.G = G; S.c = c; S.A = (const char*)(ws + WS_H); S.B = (const char*)(ws + WS_WGU); S.ta = (size_t)256 * DM * 2; S.tb = (size_t)256 * DM * 2;
            pg8::EpiSwiglu E{(bf16*)(ws + WS_GATES)};
#pragma unroll 1
            for (int rep = 0; rep < 1 + DUP_GEMM; ++rep) { pg8::gemm_phase<pg8::EpiSwiglu, pg8::SchedGrid, true, true>(lds, g, S, E, wv0); __syncthreads(); }
        }
        GBAR();
        if (DUP_SYNC) { GBAR(); GBAR(); }
        FRESH();
        if (PH(10)) {
            pg8::Gemm g{DFF, DFF, DFF}; pg8::SchedGrid S; S.to.init(T / 256, DM / 256); S.G = G; S.c = c; S.A = (const char*)(ws + WS_GATES); S.B = (const char*)(ws + WS_WDN); S.ta = (size_t)256 * DFF * 2; S.tb = (size_t)256 * DFF * 2;
            if constexpr (l + 1 < DEPTH) { pg8::EpiRes<true, true> E{(const void*)(ws + WS_X), (void*)(ws + WS_X)}; pg8::gemm_phase<pg8::EpiRes<true, true>, pg8::SchedGrid, true, true>(lds, g, S, E, wv0); }
            else { pg8::EpiRes<true, false> E{(const void*)(ws + WS_X), (void*)A.out()}; pg8::gemm_phase<pg8::EpiRes<true, false>, pg8::SchedGrid, true, true>(lds, g, S, E, wv0); }
        }
}

__global__ void __launch_bounds__(512, 2) fwd_megakernel(Args KA) {
    extern __shared__ __attribute__((aligned(16))) unsigned char lds_raw[];
    LAS unsigned char* lds = (LAS unsigned char*)lds_raw;
    const int wv0 = __builtin_amdgcn_readfirstlane(threadIdx.x >> 6);
    {
        LAS unsigned long long* tb = (LAS unsigned long long*)(lds + LDS_BYTES - 256);
        if (threadIdx.x == 0) {
            tb[0] = (unsigned long long)KA.in[0]; tb[1] = (unsigned long long)KA.in[1]; tb[2] = (unsigned long long)KA.in[2]; tb[3] = (unsigned long long)KA.in[3]; tb[4] = (unsigned long long)KA.in[4];
            tb[5] = (unsigned long long)KA.in[5]; tb[6] = (unsigned long long)KA.in[6]; tb[7] = (unsigned long long)KA.in[7]; tb[8] = (unsigned long long)KA.in[8]; tb[9] = (unsigned long long)KA.in[9];
            tb[10] = (unsigned long long)KA.in[10]; tb[11] = (unsigned long long)KA.in[11]; tb[12] = (unsigned long long)KA.in[12]; tb[13] = (unsigned long long)KA.in[13]; tb[14] = (unsigned long long)KA.in[14];
            tb[15] = (unsigned long long)KA.in[15]; tb[16] = (unsigned long long)KA.in[16]; tb[17] = (unsigned long long)KA.in[17]; tb[18] = (unsigned long long)KA.in[18]; tb[19] = (unsigned long long)KA.in[19];
            tb[20] = (unsigned long long)KA.out; tb[21] = (unsigned long long)KA.ws;
        }
        if (threadIdx.x < 2) ((LAS unsigned*)(lds + LDS_BYTES - 64))[threadIdx.x] = 0u;
        __syncthreads();
    }
    (void)xcd_barrier_post((unsigned*)(KA.ws + WS_CTL), (volatile LAS unsigned*)(lds + LDS_BYTES - 64), threadIdx.x == 0);
    Ptrs A; A.base = (unsigned)(size_t)(lds + LDS_BYTES - 256);
    layer_body<0>(A, lds, lds_raw, wv0);
    GBAR();
    layer_body<1>(A, lds, lds_raw, wv0);
}

extern "C" void kernel_launch(void* const* d_in, const int* in_sizes, int n_in, void* d_out, int out_size, void* d_ws, size_t ws_size, hipStream_t stream) {
    static int grid = 0;
    if (grid == 0) {
        if (n_in != 20 || in_sizes[0] != T * DM || out_size != T * DM || ws_size < WS_END) {
            fprintf(stderr, "kernel_launch: unexpected shapes (n_in %d, in0 %d, out %d, ws %zu need %zu)\n", n_in, n_in > 0 ? in_sizes[0] : -1, out_size, ws_size, (size_t)WS_END); grid = -1; return; }
        int dev = 0, cus = 0, per_cu = 0;
        (void)hipGetDevice(&dev); (void)hipDeviceGetAttribute(&cus, hipDeviceAttributeMultiprocessorCount, dev);
        if (hipFuncSetAttribute((const void*)fwd_megakernel, hipFuncAttributeMaxDynamicSharedMemorySize, LDS_BYTES) != hipSuccess) { fprintf(stderr, "kernel_launch: hipFuncSetAttribute failed\n"); grid = -1; return; }
        if (hipOccupancyMaxActiveBlocksPerMultiprocessor(&per_cu, (const void*)fwd_megakernel, 512, LDS_BYTES) != hipSuccess || per_cu < 1) { fprintf(stderr, "kernel_launch: occupancy query failed (%d)\n", per_cu); per_cu = 1; }
        (void)hipGetLastError();
        grid = cus * per_cu;
    }
    if (grid < 0) return;
    Args a{};
    for (int i = 0; i < 20; ++i) a.in[i] = (const float*)d_in[i];
    a.out = (float*)d_out; a.ws = (unsigned char*)d_ws;
    if (hipMemsetAsync((char*)d_ws + WS_CTL, 0, CTL_BYTES, stream) != hipSuccess) { fprintf(stderr, "kernel_launch: memset failed\n"); return; }
    void* args[] = {&a};
    hipError_t e = hipLaunchCooperativeKernel((const void*)fwd_megakernel, dim3(grid), dim3(512), args, LDS_BYTES, stream);
    if (e != hipSuccess) fprintf(stderr, "kernel_launch: cooperative launch failed: %s (grid %d)\n", hipGetErrorString(e), grid);
}
```

```cpp
#include <hip/hip_runtime.h>
#include <hip/hip_cooperative_groups.h>
#include <cstdio>
#include <cstdint>
namespace cg = cooperative_groups;

#define LAS __attribute__((address_space(3)))
typedef unsigned short bf16;
typedef short bf16x8 __attribute__((ext_vector_type(8)));
typedef short s16x4 __attribute__((ext_vector_type(4)));
typedef float f32x2 __attribute__((ext_vector_type(2)));
typedef float f32x4 __attribute__((ext_vector_type(4)));
typedef float f32x16 __attribute__((ext_vector_type(16)));
typedef unsigned u32x2 __attribute__((ext_vector_type(2)));
typedef unsigned u32x4 __attribute__((ext_vector_type(4)));

constexpr int T = 16384, DM = 2048, NMEM = 256, DFF = 5632, INW = 13328, NP = 13312, DEPTH = 2;
constexpr float EPS = 1e-6f;
constexpr float LOG2E = 1.4426950408889634f;

constexpr size_t MiB = 1u << 20;
constexpr size_t WS_WIN = 0;
constexpr size_t WS_WBR = 52 * MiB;
constexpr size_t WS_WO = 64 * MiB;
constexpr size_t WS_WGU = 72 * MiB;
constexpr size_t WS_WDN = 116 * MiB;
constexpr size_t WS_WMK = 138 * MiB;
constexpr size_t WS_H = 154 * MiB;
constexpr size_t WS_GQ = 218 * MiB;
constexpr size_t WS_GK = 234 * MiB;
constexpr size_t WS_GV = 250 * MiB;
constexpr size_t WS_GR = 282 * MiB;
constexpr size_t WS_SQ = 314 * MiB;
constexpr size_t WS_SK = 346 * MiB;
constexpr size_t WS_SV = 378 * MiB;
constexpr size_t WS_MQ = 410 * MiB;
constexpr size_t WS_GATES = 442 * MiB;
constexpr size_t WS_ABR = 634 * MiB;
constexpr size_t WS_GA1 = 730 * MiB;
constexpr size_t WS_DEC = 731 * MiB;
constexpr size_t WS_MEMKV = 732 * MiB;
constexpr size_t WS_HM = 736 * MiB;
constexpr size_t WS_KN = 738 * MiB;
constexpr size_t WS_VT = 739 * MiB;
constexpr size_t WS_CTL = 740 * MiB;
constexpr size_t CTL_BYTES = 16384;
constexpr size_t WS_X = 741 * MiB;
constexpr size_t WS_END = 805 * MiB;
constexpr int LDS_BYTES = 147456;

__device__ __forceinline__ unsigned f2bf(float f) { unsigned u = __builtin_bit_cast(unsigned, f); return (u + 0x7fffu + ((u >> 16) & 1u)) >> 16; }
__device__ __forceinline__ unsigned pk2(float lo, float hi) { return f2bf(lo) | (f2bf(hi) << 16); }
__device__ __forceinline__ float bf2f(unsigned short b) { return __builtin_bit_cast(float, ((unsigned)b) << 16); }
__device__ __forceinline__ float bflo(unsigned w) { return __builtin_bit_cast(float, w << 16); }
__device__ __forceinline__ float bfhi(unsigned w) { return __builtin_bit_cast(float, w & 0xffff0000u); }
__device__ __forceinline__ unsigned cvtpk(float lo, float hi) { unsigned r; asm volatile("v_cvt_pk_bf16_f32 %0, %1, %2" : "=v"(r) : "v"(lo), "v"(hi)); return r; }
template <int PAT> __device__ __forceinline__ float swz(float v) { return __builtin_bit_cast(float, __builtin_amdgcn_ds_swizzle(__builtin_bit_cast(int, v), PAT)); }
__device__ __forceinline__ float swap16_sum(float v) { return v + swz<0x401F>(v); }
__device__ __forceinline__ float swap32_sum(float v) {
    const unsigned u = __builtin_bit_cast(unsigned, v); auto r = __builtin_amdgcn_permlane32_swap(u, u, false, false);
    const bool hi = __builtin_amdgcn_mbcnt_lo(~0u, 0u) == 32u; return v + __builtin_bit_cast(float, hi ? r[0] : r[1]); }
template <int CTRL> __device__ __forceinline__ float dppf(float v) { return __builtin_bit_cast(float, __builtin_amdgcn_update_dpp(0, __builtin_bit_cast(int, v), CTRL, 0xf, 0xf, true)); }
__device__ __forceinline__ float red4(float v) { v += dppf<0xB1>(v); v += dppf<0x4E>(v); return v; }
__device__ __forceinline__ float red8(float v) { v = red4(v); v += dppf<0x141>(v); return v; }
__device__ __forceinline__ float red16(float v) { v = red8(v); v += dppf<0x140>(v); return v; }
__device__ __forceinline__ float red32(float v) { return swap16_sum(red16(v)); }
__device__ __forceinline__ float wave_sum(float v) { return swap32_sum(red32(v)); }
__device__ __forceinline__ int crow(int r, int hi) { return (r & 3) + 8 * (r >> 2) + 4 * hi; }
__device__ __forceinline__ int opaque_s(int x) { asm volatile("" : "+s"(x)); return x; }
__device__ __forceinline__ unsigned char* opaque_p(unsigned char* p) { __attribute__((address_space(1))) unsigned char* g = (__attribute__((address_space(1))) unsigned char*)p; asm volatile("" : "+s"(g)); return (unsigned char*)g; }
#define TID() (wv0 * 64 + (int)__builtin_amdgcn_mbcnt_hi(~0u, __builtin_amdgcn_mbcnt_lo(~0u, 0u)))
__device__ __forceinline__ int opaque(int x) { asm volatile("" : "+v"(x)); return x; }
#define LDS_WAIT() asm volatile("s_waitcnt lgkmcnt(0)" ::: "memory")
#define SBAR() __builtin_amdgcn_sched_barrier(0)

namespace pg8 {
#define PG8_LAS __attribute__((address_space(3)))
constexpr int BM = 256, BK = 64, HALF = 128, HTB = HALF * BK * 2, STAGE_BYTES = 8 * HTB, NXCD = 8, WGM = 4;
__host__ __device__ __forceinline__ int lds_byte(int r, int c) { const int st = (r >> 4) * 2 + (c >> 5), rr = r & 15, cc = c & 31, ob = rr * 64 + cc * 2; return st * 1024 + (ob ^ (((ob >> 9) & 1) << 5)); }
__host__ __device__ __forceinline__ void stage_rc(int b, int& R, int& C) { const int st = b / 1024, sb = b % 1024, swz = sb ^ (((sb >> 9) & 1) << 5); R = (st >> 1) * 16 + swz / 64; C = (st & 1) * 32 + (swz % 64) / 2; }
__host__ __device__ __forceinline__ int perm32(int rho) { const int n = rho >> 4, i = rho & 15; return 8 * (i >> 2) + 4 * n + (i & 3); }

struct Unit { int pm, pn, aux; const char* a; const char* b; };
struct Gemm { int K, lda, ldb; };

struct TileOrder {
    int nM, nN, nwg;
    __device__ __forceinline__ void init(int nM_, int nN_) { nM = nM_; nN = nN_; nwg = nM * nN; }
    __device__ __forceinline__ bool get(long L, int& pm, int& pn) const {
        if (L >= nwg) return false;
        int wgid = (int)L; { const int q = nwg / NXCD, r = nwg % NXCD, xcd = wgid % NXCD, off = wgid / NXCD; wgid = (xcd < r ? xcd * (q + 1) : r * (q + 1) + (xcd - r) * q) + off; }
        const int nig = WGM * nN, gid = wgid / nig, fm = gid * WGM, gsz = (nM - fm) < WGM ? (nM - fm) : WGM;
        pm = fm + ((wgid % nig) % gsz); pn = (wgid % nig) / gsz; return true;
    }
};
struct SchedGrid {
    TileOrder to; int G, c; const char* A; const char* B; size_t ta, tb;
    __device__ __forceinline__ bool next(int i, Unit& u) const { int pm, pn; if (!to.get((long)i * G + c, pm, pn)) return false; u.pm = pm; u.pn = pn; u.aux = 0; u.a = A + (size_t)pm * ta; u.b = B + (size_t)pn * tb; return true; }
};
struct SchedBranch {
    TileOrder to; int G, c; const char* A; const char* B;
    __device__ __forceinline__ bool next(int i, Unit& u) const { int pm, pn; const int tl = i / 3, br = i - tl * 3; if (!to.get((long)tl * G + c, pm, pn)) return false; u.pm = pm; u.pn = pn; u.aux = br;
        u.a = A + ((size_t)br * T + (size_t)pm * 256) * 1024 * 2; u.b = B + ((size_t)br * 2048 + (size_t)pn * 256) * 1024 * 2; return true; }
};
struct SchedOne {
    Unit one;
    __device__ __forceinline__ bool next(int i, Unit& u) const { if (i != 0) return false; u = one; return true; }
};

__device__ __forceinline__ float sigmoid_f(float x) { return __builtin_amdgcn_rcpf(1.0f + __builtin_amdgcn_exp2f(-x * LOG2E)); }

struct EpiProj {
    static constexpr bool PERM = true, AFTER_DRAIN = false;
    unsigned char* ws;
    __device__ __forceinline__ void operator()(const f32x4 (&acc)[2][2][4][2], const Unit& u, int wr, int wc, int fr, int fq) const {
        const int row0 = u.pm * BM + wr * 64 + fr; int colt = u.pn * BM; bf16* base; int ld; bool sg = false;
        if (colt < 512) { base = (bf16*)(ws + WS_GQ); ld = 512; }
        else if (colt < 1024) { base = (bf16*)(ws + WS_GK); ld = 512; colt -= 512; }
        else if (colt < 2048) { base = (bf16*)(ws + WS_GV); ld = 1024; colt -= 1024; }
        else if (colt < 3072) { base = (bf16*)(ws + WS_GR); ld = 1024; colt -= 2048; }
        else if (colt < 7168) { const int blk = (colt - 3072) >> 10; base = (bf16*)(ws + WS_SQ) + (size_t)blk * T * 1024; ld = 1024; colt = (colt - 3072) & 1023; }
        else { base = (bf16*)(ws + WS_GATES); ld = 6144; colt -= 7168; sg = true; }
        const int col0 = colt + wc * 32 + 8 * fq;
        if (sg) {
            const int tidx = ((wr * 4 + wc) * 64 + fq * 16 + fr);
            u32x2* gb = (u32x2*)(ws + WS_GATES) + ((size_t)(u.pm * 24 + (u.pn - 28)) * 16) * 512 + tidx;
#pragma unroll
            for (int ai = 0; ai < 2; ++ai)
#pragma unroll
                for (int m = 0; m < 4; ++m)
#pragma unroll
                    for (int bj = 0; bj < 2; ++bj) { const f32x4 v0 = acc[ai][bj][m][0], v1 = acc[ai][bj][m][1]; unsigned lo = 0u, hi = 0u;
#pragma unroll
                        for (int j = 0; j < 4; ++j) { lo |= max((unsigned)(sigmoid_f(v0[j]) * 255.0f + 0.5f), 1u) << (8 * j); hi |= max((unsigned)(sigmoid_f(v1[j]) * 255.0f + 0.5f), 1u) << (8 * j); }
                        u32x2 w; w.x = lo; w.y = hi; gb[(size_t)((ai * 4 + m) * 2 + bj) * 512] = w; }
            return;
        }
#pragma unroll
        for (int ai = 0; ai < 2; ++ai)
#pragma unroll
            for (int m = 0; m < 4; ++m) { bf16* rowp = base + (size_t)(row0 + ai * HALF + m * 16) * ld + col0;
#pragma unroll
                for (int bj = 0; bj < 2; ++bj) { f32x4 v0 = acc[ai][bj][m][0], v1 = acc[ai][bj][m][1];
                    if (sg) {
#pragma unroll
                        for (int j = 0; j < 4; ++j) { v0[j] = sigmoid_f(v0[j]); v1[j] = sigmoid_f(v1[j]); } }
                    u32x4 w; w.x = cvtpk(v0[0], v0[1]); w.y = cvtpk(v0[2], v0[3]); w.z = cvtpk(v1[0], v1[1]); w.w = cvtpk(v1[2], v1[3]);
                    *(u32x4*)(rowp + bj * HALF) = w; } }
    }
};
struct EpiBf16 {
    static constexpr bool PERM = true, AFTER_DRAIN = false;
    bf16* O; int ldc;
    __device__ __forceinline__ void operator()(const f32x4 (&acc)[2][2][4][2], const Unit& u, int wr, int wc, int fr, int fq) const {
        const int row0 = u.pm * BM + wr * 64 + fr; const int col0 = u.pn * BM + wc * 32 + 8 * fq;
#pragma unroll
        for (int ai = 0; ai < 2; ++ai)
#pragma unroll
            for (int m = 0; m < 4; ++m) { bf16* rowp = O + (size_t)(row0 + ai * HALF + m * 16) * ldc + col0;
#pragma unroll
                for (int bj = 0; bj < 2; ++bj) { const f32x4 v0 = acc[ai][bj][m][0], v1 = acc[ai][bj][m][1];
                    u32x4 w; w.x = cvtpk(v0[0], v0[1]); w.y = cvtpk(v0[2], v0[3]); w.z = cvtpk(v1[0], v1[1]); w.w = cvtpk(v1[2], v1[3]);
                    *(u32x4*)(rowp + bj * HALF) = w; } }
    }
};
struct EpiSwiglu {
    static constexpr bool PERM = true, AFTER_DRAIN = false;
    bf16* O;
    __device__ __forceinline__ void operator()(const f32x4 (&acc)[2][2][4][2], const Unit& u, int wr, int wc, int fr, int fq) const {
        const int row0 = u.pm * BM + wr * 64 + fr; const int col0 = u.pn * HALF + wc * 32 + 8 * fq;
#pragma unroll
        for (int ai = 0; ai < 2; ++ai)
#pragma unroll
            for (int m = 0; m < 4; ++m) { bf16* rowp = O + (size_t)(row0 + ai * HALF + m * 16) * DFF + col0;
                f32x4 g0 = acc[ai][0][m][0], g1 = acc[ai][0][m][1]; const f32x4 u0 = acc[ai][1][m][0], u1 = acc[ai][1][m][1];
#pragma unroll
                for (int j = 0; j < 4; ++j) { g0[j] = g0[j] * sigmoid_f(g0[j]) * u0[j]; g1[j] = g1[j] * sigmoid_f(g1[j]) * u1[j]; }
                u32x4 w; w.x = cvtpk(g0[0], g0[1]); w.y = cvtpk(g0[2], g0[3]); w.z = cvtpk(g1[0], g1[1]); w.w = cvtpk(g1[2], g1[3]);
                *(u32x4*)rowp = w; }
    }
};
struct EpiMerge {
    static constexpr bool PERM = true, AFTER_DRAIN = false, KEEP_ACC = true;
    const unsigned char* gates; bf16* mg;
    __device__ __forceinline__ void operator()(const f32x4 (&)[2][2][4][2], const Unit&, int, int, int, int) const {}
    __device__ __forceinline__ void mid(f32x4 (&acc)[2][2][4][2], const Unit& u, int wr, int wc, int fr, int fq) const {
        const int row0 = u.pm * BM + wr * 64 + fr; const int col0 = u.pn * BM + wc * 32 + 8 * fq; const int br = u.aux;
        const int tidx = (wr * 4 + wc) * 64 + fq * 16 + fr;
        const u32x2* gnum = (const u32x2*)gates + ((size_t)(u.pm * 24 + br * 8 + u.pn) * 16) * 512 + tidx;
        const u32x2* gden = (const u32x2*)gates + ((size_t)(u.pm * 24 + (br < 2 ? br + 1 : 2) * 8 + u.pn) * 16) * 512 + tidx;
#pragma unroll
        for (int ai = 0; ai < 2; ++ai) {
            u32x2 gn[8], gd[8];
#pragma unroll
            for (int q = 0; q < 8; ++q) { gn[q] = gnum[(size_t)(ai * 8 + q) * 512]; if (br < 2) gd[q] = gden[(size_t)(ai * 8 + q) * 512]; }
#pragma unroll
            for (int m = 0; m < 4; ++m)
#pragma unroll
                for (int bj = 0; bj < 2; ++bj) { const int q = m * 2 + bj; const u32x2 n = gn[q]; f32x4 s0, s1;
                    s0[0] = (float)(n.x & 0xffu); s0[1] = (float)((n.x >> 8) & 0xffu); s0[2] = (float)((n.x >> 16) & 0xffu); s0[3] = (float)(n.x >> 24);
                    s1[0] = (float)(n.y & 0xffu); s1[1] = (float)((n.y >> 8) & 0xffu); s1[2] = (float)((n.y >> 16) & 0xffu); s1[3] = (float)(n.y >> 24);
                    if (br < 2) { const u32x2 d = gd[q];
                        s0[0] *= __builtin_amdgcn_rcpf((float)(d.x & 0xffu)); s0[1] *= __builtin_amdgcn_rcpf((float)((d.x >> 8) & 0xffu)); s0[2] *= __builtin_amdgcn_rcpf((float)((d.x >> 16) & 0xffu)); s0[3] *= __builtin_amdgcn_rcpf((float)(d.x >> 24));
                        s1[0] *= __builtin_amdgcn_rcpf((float)(d.y & 0xffu)); s1[1] *= __builtin_amdgcn_rcpf((float)((d.y >> 8) & 0xffu)); s1[2] *= __builtin_amdgcn_rcpf((float)((d.y >> 16) & 0xffu)); s1[3] *= __builtin_amdgcn_rcpf((float)(d.y >> 24));
                        acc[ai][bj][m][0] *= s0; acc[ai][bj][m][1] *= s1;
                    } else { constexpr float I255 = 1.0f / 255.0f; const f32x4 v0 = acc[ai][bj][m][0] * s0 * I255, v1 = acc[ai][bj][m][1] * s1 * I255;
                        u32x4 w; w.x = cvtpk(v0[0], v0[1]); w.y = cvtpk(v0[2], v0[3]); w.z = cvtpk(v1[0], v1[1]); w.w = cvtpk(v1[2], v1[3]);
                        *(u32x4*)(mg + (size_t)(row0 + ai * HALF + m * 16) * 2048 + col0 + bj * HALF) = w;
                        acc[ai][bj][m][0] = (f32x4){0.f, 0.f, 0.f, 0.f}; acc[ai][bj][m][1] = (f32x4){0.f, 0.f, 0.f, 0.f}; } }
        }
    }
};
template <bool BASE_BF, bool OUT_BF>
struct EpiRes {
    static constexpr bool PERM = true, AFTER_DRAIN = false;
    const void* base; void* out;
    __device__ __forceinline__ void operator()(const f32x4 (&acc)[2][2][4][2], const Unit& u, int wr, int wc, int fr, int fq) const {
        const int row0 = u.pm * BM + wr * 64 + fr, col0 = u.pn * BM + wc * 32 + 8 * fq;
#pragma unroll
        for (int ai = 0; ai < 2; ++ai)
#pragma unroll
            for (int mp = 0; mp < 2; ++mp) {
                f32x4 b0[2][2], b1[2][2];
#pragma unroll
                for (int mm = 0; mm < 2; ++mm)
#pragma unroll
                    for (int bj = 0; bj < 2; ++bj) { const size_t off = (size_t)(row0 + ai * HALF + (2 * mp + mm) * 16) * 2048 + col0 + bj * HALF;
                        if (BASE_BF) { const u32x4 w = *(const u32x4*)((const bf16*)base + off);
                            b0[mm][bj] = (f32x4){bflo(w.x), bfhi(w.x), bflo(w.y), bfhi(w.y)}; b1[mm][bj] = (f32x4){bflo(w.z), bfhi(w.z), bflo(w.w), bfhi(w.w)}; }
                        else { b0[mm][bj] = *(const f32x4*)((const float*)base + off); b1[mm][bj] = *(const f32x4*)((const float*)base + off + 4); } }
#pragma unroll
                for (int mm = 0; mm < 2; ++mm)
#pragma unroll
                    for (int bj = 0; bj < 2; ++bj) { const int m = 2 * mp + mm; const size_t off = (size_t)(row0 + ai * HALF + m * 16) * 2048 + col0 + bj * HALF;
                        const f32x4 v0 = b0[mm][bj] + acc[ai][bj][m][0], v1 = b1[mm][bj] + acc[ai][bj][m][1];
                        if (OUT_BF) { u32x4 w; w.x = cvtpk(v0[0], v0[1]); w.y = cvtpk(v0[2], v0[3]); w.z = cvtpk(v1[0], v1[1]); w.w = cvtpk(v1[2], v1[3]); *(u32x4*)((bf16*)out + off) = w; }
                        else { *(f32x4*)((float*)out + off) = v0; *(f32x4*)((float*)out + off + 4) = v1; } }
            }
    }
};
struct EpiSoftmax {
    static constexpr bool PERM = true, AFTER_DRAIN = true;
    bf16* P;
    __device__ __forceinline__ void operator()(const f32x4 (&)[2][2][4][2], const Unit&, int, int, int, int) const {}
    __device__ __forceinline__ void fused(f32x4 (&acc)[2][2][4][2], const Unit& u, int wr, int wc, int fr, int fq, PG8_LAS unsigned char* lds, int wid, int lane) const {
        PG8_LAS float* S = (PG8_LAS float*)lds;
#pragma unroll
        for (int ai = 0; ai < 2; ++ai)
#pragma unroll
            for (int m = 0; m < 4; ++m) { float s = 0.f;
#pragma unroll
                for (int bj = 0; bj < 2; ++bj)
#pragma unroll
                    for (int n = 0; n < 2; ++n) { f32x4 x = acc[ai][bj][m][n];
#pragma unroll
                        for (int j = 0; j < 4; ++j) x[j] = __builtin_amdgcn_exp2f(x[j]);
                        acc[ai][bj][m][n] = x; s += (x[0] + x[1]) + (x[2] + x[3]); }
                s = swap32_sum(swap16_sum(s));
                if (fq == 0) S[(ai * HALF + wr * 64 + m * 16 + fr) * 4 + wc] = s; }
        asm volatile("s_waitcnt lgkmcnt(0)" ::: "memory"); __builtin_amdgcn_s_barrier(); asm volatile("" ::: "memory");
        const int row0 = u.pm * BM + wr * 64 + fr; const int col0 = u.pn * BM + wc * 32 + 8 * fq;
#pragma unroll
        for (int ai = 0; ai < 2; ++ai)
#pragma unroll
            for (int m = 0; m < 4; ++m) { const int rl = ai * HALF + wr * 64 + m * 16 + fr; const f32x4 pp = *(const PG8_LAS f32x4*)(S + rl * 4);
                const float rinv = 1.0f / ((pp[0] + pp[1]) + (pp[2] + pp[3]));
                bf16* rowp = P + (size_t)(row0 + ai * HALF + m * 16) * 1024 + col0;
#pragma unroll
                for (int bj = 0; bj < 2; ++bj) { const f32x4 v0 = acc[ai][bj][m][0] * rinv, v1 = acc[ai][bj][m][1] * rinv;
                    u32x4 w; w.x = cvtpk(v0[0], v0[1]); w.y = cvtpk(v0[2], v0[3]); w.z = cvtpk(v1[0], v1[1]); w.w = cvtpk(v1[2], v1[3]);
                    *(u32x4*)(rowp + bj * HALF) = w; } }
    }
};

template <class E, class = void> struct epi_keeps_acc { static constexpr bool value = false; };
template <class E> struct epi_keeps_acc<E, decltype((void)E::KEEP_ACC)> { static constexpr bool value = E::KEEP_ACC; };
template <class Epi, class Sched, bool ALIGN_EPI = false, bool SP2 = false>
__device__ __forceinline__ void gemm_phase(PG8_LAS unsigned char* lds, const Gemm g, const Sched& S, const Epi& E, const int wv0) {
    const int tid = opaque(TID()), wid = __builtin_amdgcn_readfirstlane(tid >> 6), lane = tid & 63, wr = wid >> 2, wc = wid & 3, fr = lane & 15, fq = lane >> 4;
    const int K = g.K, nt = K / BK;
    unsigned voffA[2], voffB[2];
#pragma unroll
    for (int i = 0; i < 2; ++i) { int R, C; stage_rc(tid * 16 + i * 8192, R, C); const int Rb = Epi::PERM ? ((R & ~31) + perm32(R & 31)) : R;
        voffA[i] = (unsigned)(R * g.lda + C) * 2u; voffB[i] = (unsigned)(Rb * g.ldb + C) * 2u; }
    const size_t kstep = (size_t)(BK * 2);
    const size_t hstepA = (size_t)HALF * g.lda * 2, hstepB = (size_t)HALF * g.ldb * 2;
    const unsigned ldsw = (unsigned)wid * 1024u;
    const int aoff = lds_byte(wr * 64 + fr, fq * 8), boff = lds_byte(wc * 32 + fr, fq * 8);
#define PG8_SA(b, h) (((b) * 2 + (h)) * HTB)
#define PG8_SB(b, h) ((4 + (b) * 2 + (h)) * HTB)
#define PG8_STAGE(bufoff, gbase, voff) do { _Pragma("unroll") for (int _i = 0; _i < 2; ++_i) \
        __builtin_amdgcn_global_load_lds((const unsigned*)((const char*)(gbase) + (voff)[_i]), (PG8_LAS unsigned*)(lds + (bufoff) + ldsw + _i * 8192), 16, 0, 0); } while (0)
#define PG8_LDA(dst, b, h) do { _Pragma("unroll") for (int m = 0; m < 4; ++m) _Pragma("unroll") for (int k = 0; k < 2; ++k) dst[m][k] = *(const PG8_LAS bf16x8*)(lds + PG8_SA(b, h) + aoff + m * 2048 + k * 1024); } while (0)
#define PG8_LDB(dst, b, h) do { _Pragma("unroll") for (int n = 0; n < 2; ++n) _Pragma("unroll") for (int k = 0; k < 2; ++k) dst[n][k] = *(const PG8_LAS bf16x8*)(lds + PG8_SB(b, h) + boff + n * 2048 + k * 1024); } while (0)
#define PG8_MMA(ai, bj, At, Bt) do { __builtin_amdgcn_s_setprio(1); _Pragma("unroll") for (int m = 0; m < 4; ++m) _Pragma("unroll") for (int n = 0; n < 2; ++n) _Pragma("unroll") for (int k = 0; k < 2; ++k) \
        acc[ai][bj][m][n] = __builtin_amdgcn_mfma_f32_16x16x32_bf16(Bt[n][k], At[m][k], acc[ai][bj][m][n], 0, 0, 0); __builtin_amdgcn_s_setprio(0); } while (0)
#define PG8_WAIT_V(n) asm volatile("s_waitcnt vmcnt(" #n ")" ::: "memory")
#define PG8_WAIT_L(n) asm volatile("s_waitcnt lgkmcnt(" #n ")" ::: "memory")
#define PG8_BAR __builtin_amdgcn_s_barrier()
#define PG8_SCHED __builtin_amdgcn_sched_barrier(0)
    Unit cur, nxt; int ui = 0;
    if (!S.next(0, cur)) return;
    f32x4 acc[2][2][4][2];
#pragma unroll
    for (int a = 0; a < 2; ++a)
#pragma unroll
        for (int b = 0; b < 2; ++b)
#pragma unroll
            for (int m = 0; m < 4; ++m)
#pragma unroll
                for (int n = 0; n < 2; ++n) acc[a][b][m][n] = (f32x4){0.f, 0.f, 0.f, 0.f};
    bf16x8 At[4][2], B0[2][2], B1[2][2];
    const char* cA = cur.a; const char* cB = cur.b;
    if constexpr (SP2) {
        PG8_STAGE(PG8_SB(0, 0), cB, voffB); PG8_STAGE(PG8_SB(0, 1), cB + hstepB, voffB); PG8_STAGE(PG8_SA(0, 0), cA, voffA); PG8_STAGE(PG8_SA(0, 1), cA + hstepA, voffA);
        if (wr == 1) PG8_BAR;
        PG8_WAIT_V(2); PG8_BAR;
        PG8_STAGE(PG8_SB(1, 0), cB + kstep, voffB); PG8_STAGE(PG8_SA(1, 0), cA + kstep, voffA); PG8_STAGE(PG8_SB(1, 1), cB + hstepB + kstep, voffB);
        PG8_WAIT_V(6); PG8_BAR;
    } else {
        PG8_STAGE(PG8_SB(0, 0), cB, voffB); PG8_STAGE(PG8_SA(0, 0), cA, voffA); PG8_STAGE(PG8_SB(0, 1), cB + hstepB, voffB); PG8_STAGE(PG8_SA(0, 1), cA + hstepA, voffA);
        if (wr == 1) PG8_BAR;
        PG8_WAIT_V(4); PG8_BAR;
        PG8_STAGE(PG8_SB(1, 0), cB + kstep, voffB); PG8_STAGE(PG8_SA(1, 0), cA + kstep, voffA); PG8_STAGE(PG8_SB(1, 1), cB + hstepB + kstep, voffB);
        PG8_WAIT_V(6); PG8_BAR;
    }
    for (;;) {
        const bool has_next = S.next(ui + 1, nxt);
        const char* nA = has_next ? nxt.a : cA; const char* nB = has_next ? nxt.b : cB;
        for (int t = 0; t < nt; t += 2) {
            const bool last = (t == nt - 2);
            const char* a1 = cA + (size_t)(t + 1) * kstep;
            const char* a2 = last ? nA : cA + (size_t)(t + 2) * kstep; const char* b2 = last ? nB : cB + (size_t)(t + 2) * kstep;
            const char* a3 = a2 + kstep; const char* b3 = b2 + kstep;
            if constexpr (SP2) {
            PG8_LDB(B0, 0, 0); PG8_LDB(B1, 0, 1); PG8_SCHED; PG8_LDA(At, 0, 0); PG8_STAGE(PG8_SA(1, 1), a1 + hstepA, voffA);
            PG8_WAIT_V(8); PG8_WAIT_L(0); PG8_BAR; PG8_MMA(0, 0, At, B0); PG8_MMA(0, 1, At, B1); PG8_BAR; PG8_SCHED;
            PG8_LDA(At, 0, 1); PG8_STAGE(PG8_SB(0, 0), b2, voffB); PG8_STAGE(PG8_SB(0, 1), b2 + hstepB, voffB); PG8_STAGE(PG8_SA(0, 0), a2, voffA);
            PG8_WAIT_V(8); PG8_WAIT_L(0); PG8_BAR; PG8_MMA(1, 0, At, B0); PG8_MMA(1, 1, At, B1); PG8_BAR; PG8_SCHED;
            PG8_LDB(B0, 1, 0); PG8_LDB(B1, 1, 1); PG8_SCHED; PG8_LDA(At, 1, 0); PG8_STAGE(PG8_SA(0, 1), a2 + hstepA, voffA);
            PG8_WAIT_V(8); PG8_WAIT_L(0); PG8_BAR; PG8_MMA(0, 0, At, B0); PG8_MMA(0, 1, At, B1); PG8_BAR; PG8_SCHED;
            PG8_LDA(At, 1, 1); PG8_STAGE(PG8_SB(1, 0), b3, voffB); PG8_STAGE(PG8_SB(1, 1), b3 + hstepB, voffB); PG8_STAGE(PG8_SA(1, 0), a3, voffA);
            PG8_WAIT_V(8); PG8_WAIT_L(0); PG8_BAR; PG8_MMA(1, 0, At, B0); PG8_MMA(1, 1, At, B1); PG8_BAR; PG8_SCHED;
            } else {
            PG8_LDB(B0, 0, 0); PG8_SCHED; PG8_LDA(At, 0, 0); PG8_STAGE(PG8_SA(1, 1), a1 + hstepA, voffA);
            PG8_WAIT_L(8); PG8_BAR; PG8_WAIT_L(0); PG8_MMA(0, 0, At, B0); PG8_BAR; PG8_SCHED;
            PG8_LDB(B1, 0, 1); PG8_STAGE(PG8_SB(0, 0), b2, voffB);
            PG8_BAR; PG8_WAIT_L(0); PG8_MMA(0, 1, At, B1); PG8_BAR;
            PG8_LDA(At, 0, 1); PG8_STAGE(PG8_SA(0, 0), a2, voffA);
            PG8_BAR; PG8_WAIT_L(0); PG8_MMA(1, 0, At, B0); PG8_BAR; PG8_SCHED;
            PG8_STAGE(PG8_SB(0, 1), b2 + hstepB, voffB);
            PG8_WAIT_V(6); PG8_BAR; PG8_MMA(1, 1, At, B1); PG8_BAR;
            PG8_LDB(B0, 1, 0); PG8_SCHED; PG8_LDA(At, 1, 0); PG8_STAGE(PG8_SA(0, 1), a2 + hstepA, voffA);
            PG8_WAIT_L(8); PG8_BAR; PG8_WAIT_L(0); PG8_MMA(0, 0, At, B0); PG8_BAR; PG8_SCHED;
            PG8_LDB(B1, 1, 1); PG8_STAGE(PG8_SB(1, 0), b3, voffB);
            PG8_BAR; PG8_WAIT_L(0); PG8_MMA(0, 1, At, B1); PG8_BAR;
            PG8_LDA(At, 1, 1); PG8_STAGE(PG8_SA(1, 0), a3, voffA);
            PG8_BAR; PG8_WAIT_L(0); PG8_MMA(1, 0, At, B0); PG8_BAR; PG8_SCHED;
            PG8_STAGE(PG8_SB(1, 1), b3 + hstepB, voffB);
            PG8_WAIT_V(6); PG8_BAR; PG8_MMA(1, 1, At, B1); PG8_BAR;
            }
        }
        if constexpr (ALIGN_EPI) { if (wr == 0) PG8_BAR; }
        if constexpr (epi_keeps_acc<Epi>::value) { E.mid(acc, cur, wr, wc, fr, fq); } else if constexpr (!Epi::AFTER_DRAIN) { E(acc, cur, wr, wc, fr, fq); }
        if (!has_next) break;
        if constexpr (!epi_keeps_acc<Epi>::value) {
#pragma unroll
        for (int a = 0; a < 2; ++a)
#pragma unroll
            for (int b = 0; b < 2; ++b)
#pragma unroll
                for (int m = 0; m < 4; ++m)
#pragma unroll
                    for (int n = 0; n < 2; ++n) acc[a][b][m][n] = (f32x4){0.f, 0.f, 0.f, 0.f};
        }
        cur = nxt; cA = nA; cB = nB; ++ui;
        if constexpr (ALIGN_EPI) { if (wr == 1) PG8_BAR; }
    }
    PG8_WAIT_V(0);
    if constexpr (!ALIGN_EPI) { if (wr == 0) PG8_BAR; }
    PG8_BAR;
    if constexpr (Epi::AFTER_DRAIN) { E.fused(acc, cur, wr, wc, fr, fq, lds, wid, lane); }
#undef PG8_SA
#undef PG8_SB
#undef PG8_STAGE
#undef PG8_LDA
#undef PG8_LDB
#undef PG8_MMA
#undef PG8_WAIT_V
#undef PG8_WAIT_L
#undef PG8_BAR
#undef PG8_SCHED
}
}

namespace sba {
constexpr int KVBLK = 64, LD = 1024;
constexpr size_t SHM_V = KVBLK * 128 * 2, SHM_K = KVBLK * 128 * 2;
#define KSWZ(row, colB) ((row) * 256 + ((colB) ^ (((row) & 7) << 4)))
__device__ __forceinline__ void qkt(f32x16& p0, f32x16& p1, const char* Ks, const bf16x8* qr, int r32, int hi) {
    p0 = f32x16{}; p1 = f32x16{};
#pragma unroll
    for (int d0 = 0; d0 < 8; ++d0) { const int cb = (d0 * 16 + hi * 8) * 2;
        const bf16x8 b0 = *reinterpret_cast<const bf16x8*>(Ks + KSWZ(r32, cb));
        const bf16x8 b1 = *reinterpret_cast<const bf16x8*>(Ks + KSWZ(32 + r32, cb));
        p0 = __builtin_amdgcn_mfma_f32_32x32x16_bf16(b0, qr[d0], p0, 0, 0, 0);
        p1 = __builtin_amdgcn_mfma_f32_32x32x16_bf16(b1, qr[d0], p1, 0, 0, 0); }
}
__device__ __forceinline__ int v_st(int k, int c) { const int kk = (k & ~0xC) | ((k & 4) << 1) | ((k & 8) >> 1); return ((kk >> 3) * 4 + (c >> 5)) * 512 + ((kk & 7) * 32 + (c & 31)) * 2; }
__device__ __forceinline__ int v_rd_base(int lane) { return ((lane & 3) << 3) | (((lane >> 2) & 3) << 6) | (((lane >> 4) & 1) << 5) | (((lane >> 5) & 1) << 8); }
constexpr int v_rd_off(int d0, int ks, int half) { return d0 * 512 + ks * 4096 + half * 2048; }
template <int OFF> __device__ __forceinline__ s16x4 tr_read(int vb) {
    s16x4 r; asm volatile("ds_read_b64_tr_b16 %0, %1 offset:%2" : "=&v"(r) : "v"(vb), "i"(OFF) : "memory"); return r;
}
template <int D0> __device__ __forceinline__ void pv_one(f32x16& od, int vb, bf16x8 pa0, bf16x8 pa1, bf16x8 pa2, bf16x8 pa3) {
    const s16x4 l0 = tr_read<v_rd_off(D0, 0, 0)>(vb), h0 = tr_read<v_rd_off(D0, 0, 1)>(vb), l1 = tr_read<v_rd_off(D0, 1, 0)>(vb), h1 = tr_read<v_rd_off(D0, 1, 1)>(vb);
    const s16x4 l2 = tr_read<v_rd_off(D0, 2, 0)>(vb), h2 = tr_read<v_rd_off(D0, 2, 1)>(vb), l3 = tr_read<v_rd_off(D0, 3, 0)>(vb), h3 = tr_read<v_rd_off(D0, 3, 1)>(vb);
    asm volatile("s_waitcnt lgkmcnt(0)" ::: "memory"); SBAR();
#define PK(L, H) (bf16x8){L[0], L[1], L[2], L[3], H[0], H[1], H[2], H[3]}
    od = __builtin_amdgcn_mfma_f32_32x32x16_bf16(pa0, PK(l0, h0), od, 0, 0, 0);
    od = __builtin_amdgcn_mfma_f32_32x32x16_bf16(pa1, PK(l1, h1), od, 0, 0, 0);
    od = __builtin_amdgcn_mfma_f32_32x32x16_bf16(pa2, PK(l2, h2), od, 0, 0, 0);
    od = __builtin_amdgcn_mfma_f32_32x32x16_bf16(pa3, PK(l3, h3), od, 0, 0, 0);
#undef PK
}
__device__ __forceinline__ void pv_d0(f32x16* o, int vb, bf16x8 pa0, bf16x8 pa1, bf16x8 pa2, bf16x8 pa3) {
    pv_one<0>(o[0], vb, pa0, pa1, pa2, pa3); pv_one<1>(o[1], vb, pa0, pa1, pa2, pa3); pv_one<2>(o[2], vb, pa0, pa1, pa2, pa3); pv_one<3>(o[3], vb, pa0, pa1, pa2, pa3);
}
__device__ __forceinline__ void sb_half(f32x16& p, float& carry, bool masked, int krow0, int tq, int hi) {
    float G[4];
#pragma unroll
    for (int g = 0; g < 4; ++g) {
        float q[4];
#pragma unroll
        for (int i = 0; i < 4; ++i) { const int r = 4 * g + i; const float e = __builtin_amdgcn_exp2f(p[r]); float qq = __builtin_amdgcn_rcpf(1.0f + e); float b = e * qq;
            if (masked) { const bool keep = (krow0 + crow(r, hi)) < tq; qq = keep ? qq : 1.0f; b = keep ? b : 0.0f; }
            q[i] = qq; p[r] = b; }
        const float s2 = q[3] * q[2], s1 = s2 * q[1]; G[g] = s1 * q[0];
        p[4 * g + 2] *= q[3]; p[4 * g + 1] *= s2; p[4 * g] *= s1;
    }
    float run = carry;
#pragma unroll
    for (int g = 3; g >= 0; --g) { const unsigned gu = __builtin_bit_cast(unsigned, G[g]); auto sw = __builtin_amdgcn_permlane32_swap(gu, gu, false, false);
        const float partner = __builtin_bit_cast(float, hi ? sw[0] : sw[1]);
        const float base = hi ? run : run * partner;
        p[4 * g] *= base; p[4 * g + 1] *= base; p[4 * g + 2] *= base; p[4 * g + 3] *= base; run *= G[g] * partner; }
    carry = run;
}
__device__ __forceinline__ void pack_p(const f32x16& p0, const f32x16& p1, bf16x8& pa0, bf16x8& pa1, bf16x8& pa2, bf16x8& pa3) {
#define PK4(P, BASE, OUT) do { unsigned a0 = cvtpk(P[BASE + 0], P[BASE + 1]), a1 = cvtpk(P[BASE + 2], P[BASE + 3]);   \
    unsigned b0 = cvtpk(P[BASE + 4], P[BASE + 5]), b1 = cvtpk(P[BASE + 6], P[BASE + 7]);                              \
    auto r0 = __builtin_amdgcn_permlane32_swap(a0, b0, false, false); auto r1 = __builtin_amdgcn_permlane32_swap(a1, b1, false, false); \
    u32x4 w = {r0[0], r1[0], r0[1], r1[1]}; OUT = *reinterpret_cast<bf16x8*>(&w); } while (0)
    PK4(p0, 0, pa0); PK4(p0, 8, pa1); PK4(p1, 0, pa2); PK4(p1, 8, pa3);
#undef PK4
}
__device__ __forceinline__ void sb_unit(const bf16* __restrict__ Qb, const bf16* __restrict__ Kh, const bf16* __restrict__ Vh, bf16* __restrict__ Ob, int q0, char* lds, const int wv0) {
    const int tid = opaque(TID()), wid = tid >> 6, lane = tid & 63, r32 = lane & 31, hi = lane >> 5;
    char* V_lds = lds; char* K_lds = lds + 2 * SHM_V;
    const int NT = (q0 + 256) / KVBLK;
    f32x16 o[4] = {}; bf16x8 qr[8];
    const int tq = q0 + wid * 32 + r32;
    const bf16* Qw = Qb + (size_t)tq * LD + hi * 8;
#pragma unroll
    for (int d0 = 0; d0 < 8; ++d0) qr[d0] = *reinterpret_cast<const bf16x8*>(Qw + d0 * 16);
    const int sr = tid >> 4, sc = (tid & 15) * 8, vst0 = v_st(sr, sc), vst1 = v_st(32 + sr, sc);
    const int vb0 = (int)(uintptr_t)V_lds + v_rd_base(lane);
    struct { bf16x8 vs0, vs1, ks0, ks1; } sr_[1];
#define K0(i) ((NT - 1 - (i)) * KVBLK)
#define SLOAD(i, k0) do { sr_[i].vs0 = *reinterpret_cast<const bf16x8*>(&Vh[(size_t)((k0) + sr) * LD + sc]); sr_[i].vs1 = *reinterpret_cast<const bf16x8*>(&Vh[(size_t)((k0) + 32 + sr) * LD + sc]); \
    sr_[i].ks0 = *reinterpret_cast<const bf16x8*>(&Kh[(size_t)((k0) + sr) * LD + sc]); sr_[i].ks1 = *reinterpret_cast<const bf16x8*>(&Kh[(size_t)((k0) + 32 + sr) * LD + sc]); } while (0)
#define SWRITE(b, i) do { *(bf16x8*)(V_lds + (b) * SHM_V + vst0) = sr_[i].vs0; *(bf16x8*)(V_lds + (b) * SHM_V + vst1) = sr_[i].vs1; const int kc = sc * 2; \
    *(bf16x8*)(K_lds + (b) * SHM_K + KSWZ(sr, kc)) = sr_[i].ks0; *(bf16x8*)(K_lds + (b) * SHM_K + KSWZ(32 + sr, kc)) = sr_[i].ks1; } while (0)
#define SWAIT() asm volatile("s_waitcnt vmcnt(0)" ::: "memory")
    f32x16 pA0, pA1, pB0, pB1; bf16x8 pa0, pa1, pa2, pa3; float carry = 1.0f;
    constexpr int SE = 0, SO = 0;
    __syncthreads();
    SLOAD(SE, K0(0)); asm volatile("s_waitcnt vmcnt(0)" ::: "memory"); SWRITE(0, SE); __syncthreads();
    qkt(pA0, pA1, K_lds, qr, r32, hi); sb_half(pA1, carry, true, K0(0) + 32, tq, hi);
    SLOAD(SO, K0(1));
    SWAIT(); SWRITE(1, SO); __syncthreads();
    volatile unsigned* votes = (volatile unsigned*)(lds + 4 * SHM_V);
    bool done = false;
    for (int j = 1; j + 1 < NT; j += 2) {
        SBAR(); qkt(pB0, pB1, K_lds + SHM_K, qr, r32, hi);
        sb_half(pA0, carry, (j - 1) < 4, K0(j - 1), tq, hi); pack_p(pA0, pA1, pa0, pa1, pa2, pa3); SBAR();
        { const int z = __all(carry == 0.0f); if (lane == 0) votes[wid] = (unsigned)z; }
        SLOAD(SO, K0(j + 1)); SBAR();
        pv_d0(o, vb0, pa0, pa1, pa2, pa3); sb_half(pB1, carry, j < 4, K0(j) + 32, tq, hi);
        __syncthreads();
        { unsigned a = 1u;
#pragma unroll
          for (int w = 0; w < 8; ++w) a &= votes[w];
          if (a) { done = true; break; } }
        SWAIT(); SWRITE(0, SE);
        __syncthreads();
        SBAR(); qkt(pA0, pA1, K_lds, qr, r32, hi);
        sb_half(pB0, carry, j < 4, K0(j), tq, hi); pack_p(pB0, pB1, pa0, pa1, pa2, pa3); SBAR();
        { const int z = __all(carry == 0.0f); if (lane == 0) votes[8 + wid] = (unsigned)z; }
        SLOAD(SE, K0(j + 2)); SBAR();
        pv_d0(o, vb0 + (int)SHM_V, pa0, pa1, pa2, pa3); sb_half(pA1, carry, (j + 1) < 4, K0(j + 1) + 32, tq, hi);
        __syncthreads();
        { unsigned a = 1u;
#pragma unroll
          for (int w = 0; w < 8; ++w) a &= votes[8 + w];
          if (a) { done = true; break; } }
        SWAIT(); SWRITE(1, SO);
        __syncthreads();
    }
    if (!done) {
        SBAR(); qkt(pB0, pB1, K_lds + SHM_K, qr, r32, hi);
        sb_half(pA0, carry, (NT - 2) < 4, K0(NT - 2), tq, hi); pack_p(pA0, pA1, pa0, pa1, pa2, pa3); SBAR();
        pv_d0(o, vb0, pa0, pa1, pa2, pa3); sb_half(pB1, carry, (NT - 1) < 4, K0(NT - 1) + 32, tq, hi);
        sb_half(pB0, carry, (NT - 1) < 4, K0(NT - 1), tq, hi); pack_p(pB0, pB1, pa0, pa1, pa2, pa3); SBAR();
        pv_d0(o, vb0 + (int)SHM_V, pa0, pa1, pa2, pa3);
    }
    bf16* Ow = Ob + (size_t)(q0 + wid * 32) * LD;
#pragma unroll
    for (int r = 0; r < 16; ++r) { const int orow = crow(r, hi);
#pragma unroll
        for (int d0 = 0; d0 < 4; ++d0) Ow[(size_t)orow * LD + d0 * 32 + r32] = (bf16)f2bf(o[d0][r]); }
#undef K0
#undef SLOAD
#undef SWRITE
#undef SWAIT
}
}

#define XB_TMO      128
#define XB_XCNT(j)  (256  + 64 * (j))
#define XB_XSUB(j)  (1280 + 64 * (j))
#define XB_XGEN(j)  (2304 + 64 * (j))
#define XB_TOP      3328
#define XB_TOPGEN   3392
#define XCD_BAR_WORDS 3456
#define XB_SPIN_CAP (1u << 18)

__device__ __forceinline__ unsigned xb_ld(unsigned* p)              { return __hip_atomic_load(p, __ATOMIC_RELAXED, __HIP_MEMORY_SCOPE_AGENT); }
__device__ __forceinline__ unsigned xb_add(unsigned* p, unsigned v) { return __hip_atomic_fetch_add(p, v, __ATOMIC_RELAXED, __HIP_MEMORY_SCOPE_AGENT); }
__device__ __forceinline__ unsigned xb_xcc_id() { return (unsigned)__builtin_amdgcn_s_getreg((3 << 11) | 20) & 0xFu; }
#define XB_SPIN(cond, bar) do { unsigned _sp = 0; while (cond) { __builtin_amdgcn_s_sleep(1); \
    if ((++_sp & 255u) == 0u) { if (xb_ld(&(bar)[XB_TMO])) break; if (_sp > XB_SPIN_CAP) { atomicAdd(&(bar)[XB_TMO], 1u); break; } } } } while (0)

struct XcdBarrier {
    unsigned* bar; unsigned x;
    volatile LAS unsigned* st;
};

__device__ __forceinline__ XcdBarrier xcd_barrier_post(unsigned* bar, volatile LAS unsigned* st, const bool TID0) {
    XcdBarrier b; b.bar = bar; b.x = xb_xcc_id(); b.st = st;
    if (TID0) (void)xb_add(&bar[XB_XCNT(b.x)], 1u);
    return b;
}
__device__ __forceinline__ void xcd_barrier_complete(unsigned* bar, unsigned x, unsigned& nloc, unsigned& nx) {
    const unsigned G = gridDim.x * gridDim.y * gridDim.z;
    unsigned sum, cnt, mine, sp = 0u;
    for (;;) {
        sum = 0u; cnt = 0u; mine = 0u;
#pragma unroll
        for (unsigned j = 0; j < 16; ++j) { const unsigned c = xb_ld(&bar[XB_XCNT(j)]); sum += c; cnt += (c > 0u) ? 1u : 0u; mine = (j == x) ? c : mine; }
        if (sum == G) break;
        __builtin_amdgcn_s_sleep(1);
        if ((++sp & 255u) == 0u) { if (xb_ld(&bar[XB_TMO])) break; if (sp > XB_SPIN_CAP) { atomicAdd(&bar[XB_TMO], 1u); break; } }
    }
    nloc = mine > 0u ? mine : 1u; nx = cnt > 0u ? cnt : 1u;
}

__device__ __forceinline__ void xcd_barrier(const XcdBarrier& b, const int wv0) {
    const bool TID0 = (opaque(TID()) == 0);
    asm volatile("s_waitcnt vmcnt(0)" ::: "memory");
    __syncthreads();
    if (TID0) {
        unsigned* bar = b.bar;
        __builtin_amdgcn_s_waitcnt(0);
        unsigned nloc = b.st[0], nx = b.st[1];
        if (nloc == 0u) { xcd_barrier_complete(bar, b.x, nloc, nx); b.st[0] = nloc; b.st[1] = nx; }
        const unsigned old = xb_add(&bar[XB_XSUB(b.x)], 1u);
        const unsigned gen = old / nloc;
        if (old + 1u == (gen + 1u) * nloc) {
            __builtin_amdgcn_fence(__ATOMIC_RELEASE, "agent");
            asm volatile("s_waitcnt vmcnt(0)" ::: "memory");
            const unsigned og = xb_add(&bar[XB_TOP], 1u);
            const unsigned tg = og / nx;
            if (og + 1u == (tg + 1u) * nx) xb_add(&bar[XB_TOPGEN], 1u);
            else XB_SPIN(xb_ld(&bar[XB_TOPGEN]) == tg, bar);
            __builtin_amdgcn_fence(__ATOMIC_ACQUIRE, "agent");
            xb_add(&bar[XB_XGEN(b.x)], 1u);
            asm volatile("s_waitcnt vmcnt(0)" ::: "memory");
        } else {
            XB_SPIN(xb_ld(&bar[XB_XGEN(b.x)]) == gen, bar);
            __builtin_amdgcn_fence(__ATOMIC_ACQUIRE, "agent");
            asm volatile("s_waitcnt vmcnt(0)" ::: "memory");
        }
    }
    __syncthreads();
}


struct Args { const float* in[20]; float* out; unsigned char* ws; };
struct Ptrs {
    unsigned base;
    __device__ __forceinline__ unsigned long long get(int k) const { unsigned a; asm volatile("v_mov_b32 %0, %1" : "=v"(a) : "s"(base)); const unsigned long long v = *(const LAS unsigned long long*)(a + 8u * (unsigned)k);
        const unsigned lo = __builtin_amdgcn_readfirstlane((unsigned)v), hi = __builtin_amdgcn_readfirstlane((unsigned)(v >> 32)); return ((unsigned long long)hi << 32) | lo; }
    __device__ __forceinline__ const float* in(int k) const { return (const float*)(const __attribute__((address_space(1))) float*)get(k); }
    __device__ __forceinline__ float* out() const { return (float*)(__attribute__((address_space(1))) float*)get(20); }
    __device__ __forceinline__ unsigned char* ws() const { return (unsigned char*)(__attribute__((address_space(1))) unsigned char*)get(21); }
};

__device__ __forceinline__ void transpose_item(const float* W, int ldw, int src_n0, int k0, bf16* WT, int K, int dst_n0, LAS float* scr, int lane) {
    float tv[32];
#pragma unroll
    for (int i = 0; i < 32; ++i) { const int kk = 2 * i + (lane >> 5); tv[i] = __builtin_nontemporal_load(&W[(size_t)(k0 + kk) * ldw + src_n0 + (lane & 31)]); }
#pragma unroll
    for (int i = 0; i < 32; ++i) { const int kk = 2 * i + (lane >> 5); scr[kk * 33 + (lane & 31)] = tv[i]; }
    LDS_WAIT(); asm volatile("" ::: "memory");
    const int c = lane & 7;
#pragma unroll
    for (int j = 0; j < 4; ++j) { const int n = (lane >> 3) + 8 * j; const LAS float* s = scr + (8 * c) * 33 + n;
        u32x4 o; o.x = pk2(s[0 * 33], s[1 * 33]); o.y = pk2(s[2 * 33], s[3 * 33]); o.z = pk2(s[4 * 33], s[5 * 33]); o.w = pk2(s[6 * 33], s[7 * 33]);
        *(u32x4*)(WT + (size_t)(dst_n0 + n) * K + k0 + 8 * c) = o; }
    LDS_WAIT(); asm volatile("" ::: "memory");
}
__device__ __forceinline__ void convert_weights(const Ptrs& A, int l, LAS unsigned char* lds, int gw, int NGW, int wave, int lane_) {
    const int lane = opaque(lane_);
    LAS float* scr = (LAS float*)(lds + wave * 16384);
    unsigned char* ws = A.ws();
    constexpr int I_IN = 32 * 416, I_BR = 16 * 64, I_O = 32 * 64, I_GU = 32 * 352, I_DN = 88 * 64, I_MK = 32 * 64;
    const int total = I_IN + 3 * I_BR + I_O + I_GU + I_DN + (l == 0 ? 2 * I_MK : 0);
    for (int it = gw; it < total; it += NGW) {
        int r = it;
        if (r < I_IN) { const int kb = r / 416, nb = r % 416, dn = 32 * nb; transpose_item(A.in(3) + (size_t)l * DM * INW, INW, dn + (dn >= 3072 ? 16 : 0), 64 * kb, (bf16*)(ws + WS_WIN), DM, dn, scr, lane); continue; } r -= I_IN;
        if (r < 3 * I_BR) { const int br = r / I_BR, q = r % I_BR, kb = q / 64, nb = q % 64; const float* W = (br == 0 ? A.in(7) : (br == 1 ? A.in(10) : A.in(15))) + (size_t)l * 1024 * DM;
            transpose_item(W, DM, 32 * nb, 64 * kb, (bf16*)(ws + WS_WBR), 1024, br * 2048 + 32 * nb, scr, lane); continue; } r -= 3 * I_BR;
        if (r < I_O) { const int kb = r / 64, nb = r % 64; transpose_item(A.in(16) + (size_t)l * DM * DM, DM, 32 * nb, 64 * kb, (bf16*)(ws + WS_WO), DM, 32 * nb, scr, lane); continue; } r -= I_O;
        if (r < I_GU) { const int kb = r / 352, nb = r % 352, dn = 32 * nb, p = dn >> 8, half = (dn >> 7) & 1, q = dn & 127;
            transpose_item(A.in(18) + (size_t)l * DM * 2 * DFF, 2 * DFF, half * DFF + 128 * p + q, 64 * kb, (bf16*)(ws + WS_WGU), DM, dn, scr, lane); continue; } r -= I_GU;
        if (r < I_DN) { const int kb = r / 64, nb = r % 64; transpose_item(A.in(19) + (size_t)l * DFF * DM, DM, 32 * nb, 64 * kb, (bf16*)(ws + WS_WDN), DFF, 32 * nb, scr, lane); continue; } r -= I_DN;
        { const int l2 = r / I_MK, q = r % I_MK, kb = q / 64, nb = q % 64; transpose_item(A.in(12) + (size_t)l2 * DM * DM, DM, 32 * nb, 64 * kb, (bf16*)(ws + WS_WMK) + (size_t)l2 * DM * DM, DM, 32 * nb, scr, lane); }
    }
}
template <bool GA, bool XBF = false>
__device__ __forceinline__ void norm_rows(const float* X, const float* gain, bf16* H, float* GA1, const LAS float* waT, int nrows, int gw, int NGW, int lane_) {
    const int lane = opaque(lane_);
    for (int m = gw; m < nrows; m += NGW) {
        f32x4 v[8]; float s = 0.f;
        if constexpr (XBF) { const u32x2* xb = (const u32x2*)((const bf16*)X + (size_t)m * DM) + lane;
#pragma unroll
            for (int j = 0; j < 8; ++j) { const u32x2 w = xb[64 * j]; v[j] = (f32x4){bflo(w.x), bfhi(w.x), bflo(w.y), bfhi(w.y)}; }
        } else { const f32x4* xr = (const f32x4*)(X + (size_t)m * DM) + lane;
#pragma unroll
            for (int j = 0; j < 8; ++j) v[j] = xr[64 * j]; }
#pragma unroll
        for (int j = 0; j < 8; ++j) s += (v[j].x * v[j].x + v[j].y * v[j].y) + (v[j].z * v[j].z + v[j].w * v[j].w);
        const float rinv = 1.0f / sqrtf(wave_sum(s) * (1.0f / DM) + EPS);
        unsigned long long* o8 = (unsigned long long*)(H + (size_t)m * DM) + lane;
#pragma unroll
        for (int j = 0; j < 8; ++j) { const f32x4 g = ((const f32x4*)gain)[lane + 64 * j]; v[j] = v[j] * rinv * g;
            o8[64 * j] = (unsigned long long)pk2(v[j].x, v[j].y) | ((unsigned long long)pk2(v[j].z, v[j].w) << 32); }
        if constexpr (GA) {
            float mine = 0.f;
#pragma unroll 1
            for (int r = 0; r < 16; ++r) { float a = 0.f;
#pragma unroll
                for (int j = 0; j < 8; ++j) { const f32x4 w = *(const LAS f32x4*)(waT + r * DM + 256 * j + 4 * lane); a += (v[j].x * w.x + v[j].y * w.y) + (v[j].z * w.z + v[j].w * w.w); }
                a = wave_sum(a); mine = (lane == r) ? a : mine; }
            if (lane < 16) GA1[(size_t)m * 16 + lane] = mine;
        }
    }
}
__device__ __forceinline__ void qknorm_one(const u32x4 w0, const u32x4 w1, bf16* base, const float* gain, const int which, const float fac) {
    float x[16];
    x[0] = bflo(w0.x); x[1] = bfhi(w0.x); x[2] = bflo(w0.y); x[3] = bfhi(w0.y); x[4] = bflo(w0.z); x[5] = bfhi(w0.z); x[6] = bflo(w0.w); x[7] = bfhi(w0.w);
    x[8] = bflo(w1.x); x[9] = bfhi(w1.x); x[10] = bflo(w1.y); x[11] = bfhi(w1.y); x[12] = bflo(w1.z); x[13] = bfhi(w1.z); x[14] = bflo(w1.w); x[15] = bfhi(w1.w);
    float s = 0.f;
#pragma unroll
    for (int e = 0; e < 16; ++e) s += x[e] * x[e];
    s = (which == 2) ? red16(s) : red8(s);
    const float rinv = fac / sqrtf(s * (which == 2 ? (1.0f / 256.0f) : (1.0f / 128.0f)) + EPS);
#pragma unroll
    for (int e = 0; e < 16; ++e) x[e] = x[e] * rinv * gain[e];
    u32x4 o0, o1; o0.x = pk2(x[0], x[1]); o0.y = pk2(x[2], x[3]); o0.z = pk2(x[4], x[5]); o0.w = pk2(x[6], x[7]);
    o1.x = pk2(x[8], x[9]); o1.y = pk2(x[10], x[11]); o1.z = pk2(x[12], x[13]); o1.w = pk2(x[14], x[15]);
    *(u32x4*)base = o0; *(u32x4*)(base + 8) = o1;
}
__device__ __forceinline__ void qknorm_rows(const Ptrs& A, int l, int gw, int NGW, int lane_) {
    const int lane = opaque(lane_);
    unsigned char* ws = A.ws();
    for (int id = gw; id < 3 * T; id += 2 * NGW) {
        const int which = id / T, row = id - which * T; const int id2 = id + NGW; const bool two = (id2 < 3 * T) && (id2 / T == which);
        bf16* base = (bf16*)(ws + (which == 0 ? WS_SQ : (which == 1 ? WS_SK : WS_MQ))) + (size_t)row * 1024 + 16 * lane;
        bf16* base2 = base + (size_t)NGW * 1024;
        const int hw = (which == 2) ? 16 : 8;
        const float* gain = (which == 0 ? A.in(8) : (which == 1 ? A.in(9) : A.in(13))) + (size_t)l * (which == 2 ? 256 : 128) + 16 * (lane & (hw - 1));
        const float fac = (which == 0) ? (0.08838834764831845f * LOG2E) : ((which == 2) ? (0.0625f * LOG2E) : 1.0f);
        const u32x4 w0 = *(const u32x4*)base, w1 = *(const u32x4*)(base + 8);
        u32x4 v0 = w0, v1 = w1;
        if (two) { v0 = *(const u32x4*)base2; v1 = *(const u32x4*)(base2 + 8); }
        qknorm_one(w0, w1, base, gain, which, fac);
        if (two) qknorm_one(v0, v1, base2, gain, which, fac);
        else if (id2 < 3 * T) {
            const int which2 = id2 / T, row2 = id2 - which2 * T;
            bf16* b2 = (bf16*)(ws + (which2 == 0 ? WS_SQ : (which2 == 1 ? WS_SK : WS_MQ))) + (size_t)row2 * 1024 + 16 * lane;
            const int hw2 = (which2 == 2) ? 16 : 8;
            const float* gain2 = (which2 == 0 ? A.in(8) : (which2 == 1 ? A.in(9) : A.in(13))) + (size_t)l * (which2 == 2 ? 256 : 128) + 16 * (lane & (hw2 - 1));
            const float fac2 = (which2 == 0) ? (0.08838834764831845f * LOG2E) : ((which2 == 2) ? (0.0625f * LOG2E) : 1.0f);
            const u32x4 y0 = *(const u32x4*)b2, y1 = *(const u32x4*)(b2 + 8);
            qknorm_one(y0, y1, b2, gain2, which2, fac2);
        }
    }
}
__device__ __forceinline__ void memkv_naive(const Ptrs& A, LAS unsigned char* lds, int wave, int lane_, const int wv0) {
    unsigned char* ws = A.ws(); const int tid = opaque(TID()), lane = tid & 63, r32 = lane & 31, hi = lane >> 5;
    LAS float* red = (LAS float*)lds;
    for (int id = blockIdx.x; id < 1024; id += gridDim.x) {
        const int l2 = id >> 9, rem = id & 511, mt = rem >> 6, nt = rem & 63;
        const bf16* hm = (const bf16*)(ws + WS_HM) + ((size_t)l2 * 256 + 32 * mt + r32) * DM + 256 * wave + 8 * hi;
        const bf16* wk = (const bf16*)(ws + WS_WMK) + ((size_t)l2 * DM + 32 * nt + r32) * DM + 256 * wave + 8 * hi;
        f32x16 acc = {};
#pragma unroll 4
        for (int s = 0; s < 16; ++s) { const bf16x8 a = *(const bf16x8*)(hm + 16 * s), b = *(const bf16x8*)(wk + 16 * s); acc = __builtin_amdgcn_mfma_f32_32x32x16_bf16(a, b, acc, 0, 0, 0); }
#pragma unroll
        for (int r = 0; r < 16; ++r) red[(wave * 16 + r) * 64 + lane] = acc[r];
        __syncthreads();
#pragma unroll
        for (int i = 0; i < 2; ++i) { const int e = tid + 512 * i, r = e >> 6, ln = e & 63; float s = 0.f;
#pragma unroll
            for (int w = 0; w < 8; ++w) s += red[(w * 16 + r) * 64 + ln];
            ((float*)(ws + WS_MEMKV))[((size_t)l2 * 256 + 32 * mt + crow(r, ln >> 5)) * DM + 32 * nt + (ln & 31)] = s; }
        __syncthreads();
    }
}
__device__ __forceinline__ void memkv_post(const Ptrs& A, int gw, int NGW, int lane_) {
    const int lane = opaque(lane_);
    unsigned char* ws = A.ws(); const float* kv = (const float*)(ws + WS_MEMKV);
    for (int id = gw; id < 2048; id += NGW) {
        const int l2 = id >> 10, hd = (id >> 8) & 3, m = id & 255;
        const f32x4 x = *(const f32x4*)(kv + ((size_t)l2 * 256 + m) * DM + hd * 256 + 4 * lane);
        const float s = wave_sum((x.x * x.x + x.y * x.y) + (x.z * x.z + x.w * x.w));
        const float rinv = 1.0f / sqrtf(s * (1.0f / 256.0f) + EPS);
        const f32x4 g = *(const f32x4*)(A.in(14) + (size_t)l2 * 256 + 4 * lane);
        *(unsigned long long*)((bf16*)(ws + WS_KN) + (((size_t)l2 * 4 + hd) * 256 + m) * 256 + 4 * lane) =
            (unsigned long long)pk2(x.x * rinv * g.x, x.y * rinv * g.y) | ((unsigned long long)pk2(x.z * rinv * g.z, x.w * rinv * g.w) << 32);
    }
    const int gt = gw * 64 + lane, NGT = NGW * 64;
    for (int id = gt; id < 65536; id += NGT) {
        const int l2 = id >> 15, row = (id >> 5) & 1023, mg = id & 31;
        const float* src = kv + ((size_t)l2 * 256 + 8 * mg) * DM + 1024 + row;
        u32x4 o; o.x = pk2(src[0], src[DM]); o.y = pk2(src[2 * DM], src[3 * DM]); o.z = pk2(src[4 * DM], src[5 * DM]); o.w = pk2(src[6 * DM], src[7 * DM]);
        *(u32x4*)((bf16*)(ws + WS_VT) + ((size_t)l2 * 1024 + row) * 256 + 8 * mg) = o;
    }
}
constexpr int BLS = 132;
__device__ __forceinline__ void gla_cumdecay(const Ptrs& A, int l, int n, int hd, LAS float* bl, const int wv0) {
    const int tid = opaque(TID()), d = tid & 127, tq = __builtin_amdgcn_readfirstlane(tid >> 7);
    const float* wa2 = A.in(4) + (size_t)l * 16 * 512 + hd * 128 + d;
    float w[16];
#pragma unroll
    for (int r = 0; r < 16; ++r) w[r] = wa2[r * 512];
    const float bias = A.in(5)[(size_t)l * 512 + hd * 128 + d];
    LAS float* gal = bl + 29184;
    *(LAS f32x2*)(gal + 2 * tid) = *(const f32x2*)((const float*)(A.ws() + WS_GA1) + (size_t)n * 64 * 16 + 2 * tid);
    __syncthreads();
    const LAS float* ga = gal + 16 * tq * 16;
    float run = 0.f;
    for (int tt = 0; tt < 16; ++tt) {
        float pre = bias;
        const f32x4 g0 = *(const LAS f32x4*)(ga + tt * 16), g1 = *(const LAS f32x4*)(ga + tt * 16 + 4), g2 = *(const LAS f32x4*)(ga + tt * 16 + 8), g3 = *(const LAS f32x4*)(ga + tt * 16 + 12);
        pre += (g0.x * w[0] + g0.y * w[1]) + (g0.z * w[2] + g0.w * w[3]); pre += (g1.x * w[4] + g1.y * w[5]) + (g1.z * w[6] + g1.w * w[7]);
        pre += (g2.x * w[8] + g2.y * w[9]) + (g2.z * w[10] + g2.w * w[11]); pre += (g3.x * w[12] + g3.y * w[13]) + (g3.z * w[14] + g3.w * w[15]);
        const float la = (fminf(pre, 0.f) - __logf(1.0f + __expf(-fabsf(pre)))) * (1.0f / 16.0f);
        run += la; bl[(16 * tq + tt) * BLS + d] = run;
    }
    __syncthreads();
    float add = 0.f;
#pragma unroll
    for (int q = 0; q < 3; ++q) if (q < tq) add += bl[(16 * q + 15) * BLS + d];
    __syncthreads();
    if (tq > 0) for (int tt = 0; tt < 16; ++tt) bl[(16 * tq + tt) * BLS + d] += add;
    __syncthreads();
}
__device__ __forceinline__ void unpack8(const u32x4 w, float* x) { x[0] = bflo(w.x); x[1] = bfhi(w.x); x[2] = bflo(w.y); x[3] = bfhi(w.y); x[4] = bflo(w.z); x[5] = bfhi(w.z); x[6] = bflo(w.w); x[7] = bfhi(w.w); }
__device__ __forceinline__ void gla_load_vt(const bf16* GVc, LAS bf16* VTl, int wave, int lane) {
    u32x4 vv[4];
#pragma unroll
    for (int i = 0; i < 4; ++i) vv[i] = *(const u32x4*)(GVc + (size_t)lane * 1024 + (wave + 8 * i) * 8);
#pragma unroll
    for (int i = 0; i < 4; ++i) { const int v0 = (wave + 8 * i) * 8; LAS bf16* p = VTl + v0 * 72 + lane;
        p[0] = (bf16)(vv[i].x & 0xffff); p[72] = (bf16)(vv[i].x >> 16); p[144] = (bf16)(vv[i].y & 0xffff); p[216] = (bf16)(vv[i].y >> 16);
        p[288] = (bf16)(vv[i].z & 0xffff); p[360] = (bf16)(vv[i].z >> 16); p[432] = (bf16)(vv[i].w & 0xffff); p[504] = (bf16)(vv[i].w >> 16); }
}
__device__ __forceinline__ void gla_state(const Ptrs& A, int l, LAS unsigned char* lds, int c, int G, int wave, int lane_, const int wv0) {
    unsigned char* ws = A.ws(); const int tid = opaque(TID()), lane = tid & 63, r32 = lane & 31, hi = lane >> 5;
    LAS float* bl = (LAS float*)lds; LAS bf16* KdT = (LAS bf16*)(lds + 33792); LAS bf16* VTl = (LAS bf16*)(lds + 33792 + 128 * 72 * 2);
    const bf16* GK = (const bf16*)(ws + WS_GK); const bf16* GV = (const bf16*)(ws + WS_GV); bf16* US = (bf16*)(ws + WS_H);
    for (int it = c; it < 1024; it += G) {
        const int n = it >> 2, hd = it & 3, t0 = n * 64;
        u32x4 kk[2];
#pragma unroll
        for (int i = 0; i < 2; ++i) kk[i] = *(const u32x4*)(GK + (size_t)(t0 + lane) * 512 + hd * 128 + (wave + 8 * i) * 8);
        gla_cumdecay(A, l, n, hd, bl, wv0);
        gla_load_vt(GV + (size_t)t0 * 1024 + hd * 256, VTl, wave, lane);
#pragma unroll
        for (int i = 0; i < 2; ++i) { const int d0 = (wave + 8 * i) * 8; float x[8]; unpack8(kk[i], x);
            const f32x4 b0 = *(const LAS f32x4*)(bl + lane * BLS + d0), b1 = *(const LAS f32x4*)(bl + lane * BLS + d0 + 4);
            const f32x4 e0 = *(const LAS f32x4*)(bl + 63 * BLS + d0), e1 = *(const LAS f32x4*)(bl + 63 * BLS + d0 + 4);
            LAS bf16* p = KdT + d0 * 72 + lane;
            p[0] = (bf16)f2bf(x[0] * __expf(e0.x - b0.x)); p[72] = (bf16)f2bf(x[1] * __expf(e0.y - b0.y)); p[144] = (bf16)f2bf(x[2] * __expf(e0.z - b0.z)); p[216] = (bf16)f2bf(x[3] * __expf(e0.w - b0.w));
            p[288] = (bf16)f2bf(x[4] * __expf(e1.x - b1.x)); p[360] = (bf16)f2bf(x[5] * __expf(e1.y - b1.y)); p[432] = (bf16)f2bf(x[6] * __expf(e1.z - b1.z)); p[504] = (bf16)f2bf(x[7] * __expf(e1.w - b1.w)); }
        if (tid < 128) ((float*)(ws + WS_DEC))[(size_t)it * 128 + tid] = __expf(bl[63 * BLS + tid]);
        __syncthreads();
        bf16x8 af[4];
#pragma unroll
        for (int ks = 0; ks < 4; ++ks) af[ks] = *(const LAS bf16x8*)(VTl + (32 * wave + r32) * 72 + 16 * ks + 8 * hi);
#pragma unroll
        for (int j = 0; j < 4; ++j) { f32x16 acc = {};
#pragma unroll
            for (int ks = 0; ks < 4; ++ks) { const bf16x8 b = *(const LAS bf16x8*)(KdT + (32 * j + r32) * 72 + 16 * ks + 8 * hi); acc = __builtin_amdgcn_mfma_f32_32x32x16_bf16(af[ks], b, acc, 0, 0, 0); }
#pragma unroll
            for (int r = 0; r < 16; ++r) US[((size_t)it * 256 + 32 * wave + crow(r, hi)) * 128 + 32 * j + r32] = (bf16)f2bf(acc[r]); }
        __syncthreads();
    }
}
__device__ __forceinline__ void gla_scan(const Ptrs& A, const int wv0) {
    const int tid = opaque(TID());
    unsigned char* ws = A.ws();
    for (int g = blockIdx.x * 512 + tid; g < 131072; g += gridDim.x * 512) {
        const int hd = g >> 15, v = (g >> 7) & 255, d = g & 127;
        bf16* us = (bf16*)(ws + WS_H) + ((size_t)hd * 256 + v) * 128 + d;
        const float* dec = (const float*)(ws + WS_DEC) + hd * 128 + d;
        float st = 0.f;
        for (int n0 = 0; n0 < 256; n0 += 64) {
            bf16 u[64]; float dc[64];
#pragma unroll
            for (int i = 0; i < 64; ++i) { u[i] = us[(size_t)(n0 + i) * 131072]; dc[i] = dec[(size_t)(n0 + i) * 512]; }
#pragma unroll
            for (int i = 0; i < 64; ++i) { us[(size_t)(n0 + i) * 131072] = (bf16)f2bf(st); st = st * dc[i] + bf2f(u[i]); }
        }
    }
}
__device__ __forceinline__ void gla_out(const Ptrs& A, int l, LAS unsigned char* lds, int c, int G, int wave, int lane_, const int wv0) {
    unsigned char* ws = A.ws(); const int tid = opaque(TID()), lane = tid & 63, r32 = lane & 31, hi = lane >> 5;
    LAS float* bl = (LAS float*)lds; LAS bf16* QE = (LAS bf16*)(lds + 33792); LAS bf16* KE = (LAS bf16*)(lds + 51200); LAS bf16* VTl = (LAS bf16*)(lds + 68608);
    LAS bf16* SM = (LAS bf16*)(lds + 105472); LAS float* red = (LAS float*)(lds + 114688);
    const bf16* GQ = (const bf16*)(ws + WS_GQ); const bf16* GK = (const bf16*)(ws + WS_GK); const bf16* GV = (const bf16*)(ws + WS_GV); const bf16* GR = (const bf16*)(ws + WS_GR);
    const bf16* US = (const bf16*)(ws + WS_H); bf16* AG = (bf16*)(ws + WS_ABR);
    const float* gout = A.in(6) + (size_t)l * 256;
    for (int it = c; it < 1024; it += G) {
        const int n = it >> 2, hd = it & 3, t0 = n * 64;
        u32x4 qq[2], kk[2];
#pragma unroll
        for (int i = 0; i < 2; ++i) { qq[i] = *(const u32x4*)(GQ + (size_t)(t0 + lane) * 512 + hd * 128 + (wave + 8 * i) * 8); kk[i] = *(const u32x4*)(GK + (size_t)(t0 + lane) * 512 + hd * 128 + (wave + 8 * i) * 8); }
        gla_cumdecay(A, l, n, hd, bl, wv0);
        gla_load_vt(GV + (size_t)t0 * 1024 + hd * 256, VTl, wave, lane);
#pragma unroll
        for (int i = 0; i < 2; ++i) { const int d0 = (wave + 8 * i) * 8; float xq[8], xk[8]; unpack8(qq[i], xq); unpack8(kk[i], xk);
            const f32x4 b0 = *(const LAS f32x4*)(bl + lane * BLS + d0), b1 = *(const LAS f32x4*)(bl + lane * BLS + d0 + 4);
            float eb[8]; eb[0] = __expf(b0.x); eb[1] = __expf(b0.y); eb[2] = __expf(b0.z); eb[3] = __expf(b0.w); eb[4] = __expf(b1.x); eb[5] = __expf(b1.y); eb[6] = __expf(b1.z); eb[7] = __expf(b1.w);
            u32x4 oq, ok;
            oq.x = pk2(xq[0] * 0.08838834764831845f * eb[0], xq[1] * 0.08838834764831845f * eb[1]); oq.y = pk2(xq[2] * 0.08838834764831845f * eb[2], xq[3] * 0.08838834764831845f * eb[3]);
            oq.z = pk2(xq[4] * 0.08838834764831845f * eb[4], xq[5] * 0.08838834764831845f * eb[5]); oq.w = pk2(xq[6] * 0.08838834764831845f * eb[6], xq[7] * 0.08838834764831845f * eb[7]);
            ok.x = pk2(xk[0] * __builtin_amdgcn_rcpf(eb[0]), xk[1] * __builtin_amdgcn_rcpf(eb[1])); ok.y = pk2(xk[2] * __builtin_amdgcn_rcpf(eb[2]), xk[3] * __builtin_amdgcn_rcpf(eb[3]));
            ok.z = pk2(xk[4] * __builtin_amdgcn_rcpf(eb[4]), xk[5] * __builtin_amdgcn_rcpf(eb[5])); ok.w = pk2(xk[6] * __builtin_amdgcn_rcpf(eb[6]), xk[7] * __builtin_amdgcn_rcpf(eb[7]));
            *(LAS u32x4*)(QE + lane * 136 + d0) = oq; *(LAS u32x4*)(KE + lane * 136 + d0) = ok; }
        __syncthreads();
        if (wave < 4) { const int ti = wave >> 1, tj = wave & 1; f32x16 acc = {};
            if (tj <= ti) {
#pragma unroll
                for (int ks = 0; ks < 8; ++ks) { const bf16x8 a = *(const LAS bf16x8*)(QE + (32 * ti + r32) * 136 + 16 * ks + 8 * hi), b = *(const LAS bf16x8*)(KE + (32 * tj + r32) * 136 + 16 * ks + 8 * hi);
                    acc = __builtin_amdgcn_mfma_f32_32x32x16_bf16(a, b, acc, 0, 0, 0); } }
#pragma unroll
            for (int r = 0; r < 16; ++r) { const int t = 32 * ti + crow(r, hi), sx = 32 * tj + r32; SM[t * 72 + sx] = (bf16)f2bf(sx <= t ? acc[r] : 0.f); } }
        __syncthreads();
        const int ti = wave & 1, vq = wave >> 1;
        f32x16 o0 = {}, o1 = {};
        {
            const bf16* sb0 = US + ((size_t)it * 256 + 64 * vq + r32) * 128 + 8 * hi; const bf16* sb1 = sb0 + 32 * 128;
#pragma unroll
            for (int ks = 0; ks < 8; ++ks) { const bf16x8 a = *(const LAS bf16x8*)(QE + (32 * ti + r32) * 136 + 16 * ks + 8 * hi);
                const bf16x8 b0 = *(const bf16x8*)(sb0 + 16 * ks), b1 = *(const bf16x8*)(sb1 + 16 * ks);
                o0 = __builtin_amdgcn_mfma_f32_32x32x16_bf16(a, b0, o0, 0, 0, 0); o1 = __builtin_amdgcn_mfma_f32_32x32x16_bf16(a, b1, o1, 0, 0, 0); }
#pragma unroll
            for (int ks = 0; ks < 4; ++ks) { const bf16x8 a = *(const LAS bf16x8*)(SM + (32 * ti + r32) * 72 + 16 * ks + 8 * hi);
                const bf16x8 b0 = *(const LAS bf16x8*)(VTl + (64 * vq + r32) * 72 + 16 * ks + 8 * hi), b1 = *(const LAS bf16x8*)(VTl + (64 * vq + 32 + r32) * 72 + 16 * ks + 8 * hi);
                o0 = __builtin_amdgcn_mfma_f32_32x32x16_bf16(a, b0, o0, 0, 0, 0); o1 = __builtin_amdgcn_mfma_f32_32x32x16_bf16(a, b1, o1, 0, 0, 0); }
        }
#pragma unroll
        for (int r = 0; r < 16; ++r) { float p = o0[r] * o0[r] + o1[r] * o1[r];
            p = red32(p);
            if (r32 == 0) red[vq * 64 + 32 * ti + crow(r, hi)] = p; }
        __syncthreads();
        const float g0 = gout[64 * vq + r32], g1 = gout[64 * vq + 32 + r32];
#pragma unroll
        for (int r = 0; r < 16; ++r) { const int t = 32 * ti + crow(r, hi);
            const float tot = (red[t] + red[64 + t]) + (red[128 + t] + red[192 + t]); const float rinv = 1.0f / sqrtf(tot * (1.0f / 256.0f) + EPS);
            const size_t off = (size_t)(t0 + t) * 1024 + hd * 256 + 64 * vq + r32;
            const float r0 = bf2f(GR[off]), r1 = bf2f(GR[off + 32]);
            AG[off] = (bf16)f2bf(o0[r] * rinv * g0 * r0 * pg8::sigmoid_f(r0)); AG[off + 32] = (bf16)f2bf(o1[r] * rinv * g1 * r1 * pg8::sigmoid_f(r1)); }
        __syncthreads();
    }
}

#ifndef PHASE_MASK
#define PHASE_MASK 0x7ff
#endif
#define PH(k) (((PHASE_MASK) >> (k)) & 1)
#ifndef DUP_GEMM
#define DUP_GEMM 0
#endif
#ifndef DUP_SYNC
#define DUP_SYNC 0
#endif
#ifndef DUP_ATTN
#define DUP_ATTN 0
#endif
#ifndef DUP_P5
#define DUP_P5 0
#endif
#define GBAR() do { XcdBarrier xb_; xb_.bar = (unsigned*)(A.ws() + WS_CTL); xb_.x = xb_xcc_id(); { unsigned a_; asm volatile("v_mov_b32 %0, %1" : "=v"(a_) : "s"(A.base + 192u)); xb_.st = (volatile LAS unsigned*)a_; } xcd_barrier(xb_, wv0); } while (0)
template <int l>
__device__ __forceinline__ void layer_body(const Ptrs& A, LAS unsigned char* lds, unsigned char* lds_raw, const int wv0) {
    unsigned char* ws; int tid, lane, wave, G, c, gw, NGW;
#define FRESH() do { ws = opaque_p(A.ws()); tid = opaque(TID()); lane = tid & 63; wave = __builtin_amdgcn_readfirstlane(tid >> 6); G = opaque_s(gridDim.x); c = opaque_s(blockIdx.x); gw = c * 8 + wave; NGW = G * 8; } while (0)


        FRESH();
        if (PH(1)) {
            convert_weights(A, l, lds, gw, NGW, wave, lane);
            __syncthreads();
            LAS float* waT = (LAS float*)lds;
            const float* win = A.in(3) + (size_t)l * DM * INW + 3072;
            for (int idx = tid; idx < 16 * DM; idx += 512) { const int k = idx >> 4, r = idx & 15; waT[r * DM + k] = win[(size_t)k * INW + r]; }
            __syncthreads();
            if constexpr (l == 0) norm_rows<true, false>(A.in(0), A.in(2) + (size_t)l * DM, (bf16*)(ws + WS_H), (float*)(ws + WS_GA1), waT, T, gw, NGW, lane);
            else norm_rows<true, true>((const float*)(ws + WS_X), A.in(2) + (size_t)l * DM, (bf16*)(ws + WS_H), (float*)(ws + WS_GA1), waT, T, gw, NGW, lane);
            if (l == 0) {
                norm_rows<false>(A.in(1), A.in(11), (bf16*)(ws + WS_HM), nullptr, waT, NMEM, gw, NGW, lane);
                norm_rows<false>(A.in(1), A.in(11) + DM, (bf16*)(ws + WS_HM) + (size_t)NMEM * DM, nullptr, waT, NMEM, gw, NGW, lane);
            }
            __syncthreads();
        }
        if constexpr (l == 0) cg::this_grid().sync(); else GBAR();
        if (DUP_SYNC) { GBAR(); GBAR(); }
        FRESH();
        if (PH(2)) {
            pg8::Gemm g{DM, DM, DM}; pg8::SchedGrid S; S.to.init(T / 256, NP / 256); S.G = G; S.c = c; S.A = (const char*)(ws + WS_H); S.B = (const char*)(ws + WS_WIN); S.ta = (size_t)256 * DM * 2; S.tb = (size_t)256 * DM * 2;
            pg8::EpiProj E{ws};
#pragma unroll 1
            for (int rep = 0; rep < 1 + DUP_GEMM; ++rep) { pg8::gemm_phase<pg8::EpiProj, pg8::SchedGrid, true, true>(lds, g, S, E, wv0); __syncthreads(); }
        }
        GBAR();
        if (DUP_SYNC) { GBAR(); GBAR(); }
        FRESH();
        if (PH(3)) {
            if (l == 0) memkv_naive(A, lds, wave, lane, wv0);
            qknorm_rows(A, l, gw, NGW, lane);
            __syncthreads();
            gla_state(A, l, lds, c, G, wave, lane, wv0);
        }
        GBAR();
        if (DUP_SYNC) { GBAR(); GBAR(); }
        FRESH();
        if (PH(4)) {
            if (l == 0) memkv_post(A, gw, NGW, lane);
            for (int u = c; u < 256 * (1 + DUP_ATTN); u += G) {
                const int head = (u & 255) >> 5, p = u & 31;
                const bf16* Q = (const bf16*)(ws + WS_SQ) + head * 128; const bf16* Kp = (const bf16*)(ws + WS_SK) + head * 128; const bf16* V = (const bf16*)(ws + WS_SV) + head * 128;
                bf16* O = (bf16*)(ws + WS_ABR) + (size_t)T * 1024 + head * 128;
#pragma unroll 1
                for (int rep = 0; rep < 2; ++rep) sba::sb_unit(Q, Kp, V, O, (rep ? p : 63 - p) * 256, (char*)lds_raw, wv0);
            }
            __syncthreads();
            gla_scan(A, wv0);
        }
        GBAR();
        if (DUP_SYNC) { GBAR(); GBAR(); }
        FRESH();
        if (PH(5)) {
#ifndef NO_MEMATT
            for (int u = c; u < 256; u += G) {
                const int pm = u >> 2, hd = u & 3;
                { pg8::Gemm g{256, 1024, 256}; pg8::SchedOne S; S.one.pm = pm; S.one.pn = hd; S.one.aux = 0;
                  S.one.a = (const char*)((const bf16*)(ws + WS_MQ) + (size_t)pm * 256 * 1024 + hd * 256); S.one.b = (const char*)((const bf16*)(ws + WS_KN) + ((size_t)l * 4 + hd) * 256 * 256);
                  pg8::EpiSoftmax E{(bf16*)(ws + WS_SQ)};
                  pg8::gemm_phase<pg8::EpiSoftmax, pg8::SchedOne, false, true>(lds, g, S, E, wv0); }
                asm volatile("s_waitcnt vmcnt(0)" ::: "memory"); __syncthreads();
                { pg8::Gemm g{256, 1024, 256}; pg8::SchedOne S; S.one.pm = pm; S.one.pn = hd; S.one.aux = 0;
                  S.one.a = (const char*)((const bf16*)(ws + WS_SQ) + (size_t)pm * 256 * 1024 + hd * 256); S.one.b = (const char*)((const bf16*)(ws + WS_VT) + ((size_t)l * 1024 + hd * 256) * 256);
                  pg8::EpiBf16 E{(bf16*)(ws + WS_ABR) + (size_t)2 * T * 1024, 1024};
                  pg8::gemm_phase<pg8::EpiBf16, pg8::SchedOne, false, true>(lds, g, S, E, wv0); }
                __syncthreads();
            }
#endif
#ifndef NO_GLAOUT
            gla_out(A, l, lds, c, G, wave, lane, wv0);
#endif
        }
        GBAR();
        if (DUP_SYNC) { GBAR(); GBAR(); }
        FRESH();
        if (PH(6)) {
            pg8::Gemm g{1024, 1024, 1024}; pg8::SchedBranch S; S.to.init(T / 256, DM / 256); S.G = G; S.c = c; S.A = (const char*)(ws + WS_ABR); S.B = (const char*)(ws + WS_WBR);
            pg8::EpiMerge E{(const unsigned char*)(ws + WS_GATES), (bf16*)(ws + WS_GV)};
#pragma unroll 1
            for (int rep = 0; rep < 1 + DUP_GEMM; ++rep) { pg8::gemm_phase<pg8::EpiMerge, pg8::SchedBranch, true, true>(lds, g, S, E, wv0); __syncthreads(); }
        }
        GBAR();
        if (DUP_SYNC) { GBAR(); GBAR(); }
        FRESH();
        if (PH(7)) {
            pg8::Gemm g{DM, DM, DM}; pg8::SchedGrid S; S.to.init(T / 256, DM / 256); S.G = G; S.c = c; S.A = (const char*)(ws + WS_GV); S.B = (const char*)(ws + WS_WO); S.ta = (size_t)256 * DM * 2; S.tb = (size_t)256 * DM * 2;
            if constexpr (l == 0) { pg8::EpiRes<false, true> E{(const void*)A.in(0), (void*)(ws + WS_X)}; pg8::gemm_phase<pg8::EpiRes<false, true>, pg8::SchedGrid, true, true>(lds, g, S, E, wv0); }
            else { pg8::EpiRes<true, true> E{(const void*)(ws + WS_X), (void*)(ws + WS_X)}; pg8::gemm_phase<pg8::EpiRes<true, true>, pg8::SchedGrid, true, true>(lds, g, S, E, wv0); }
        }
        GBAR();
        if (DUP_SYNC) { GBAR(); GBAR(); }
        FRESH();
        if (PH(8)) norm_rows<false, true>((const float*)(ws + WS_X), A.in(17) + (size_t)l * DM, (bf16*)(ws + WS_H), nullptr, (const LAS float*)lds, T, gw, NGW, lane);
        GBAR();
        if (DUP_SYNC) { GBAR(); GBAR(); }
        FRESH();
        if (PH(9)) {
            pg8::Gemm g{DM, DM, DM}; pg8::SchedGrid S; S.to.init(T / 256, 2 * DFF / 256); S.G = G; S.c = c; S.A = (const char*)(ws + WS_H); S.B = (const char*)(ws + WS_WGU); S.ta = (size_t)256 * DM * 2; S.tb = (size_t)256 * DM * 2;
            pg8::EpiSwiglu E{(bf16*)(ws + WS_GATES)};
#pragma unroll 1
            for (int rep = 0; rep < 1 + DUP_GEMM; ++rep) { pg8::gemm_phase<pg8::EpiSwiglu, pg8::SchedGrid, true, true>(lds, g, S, E, wv0); __syncthreads(); }
        }
        GBAR();
        if (DUP_SYNC) { GBAR(); GBAR(); }
        FRESH();
        if (PH(10)) {
            pg8::Gemm g{DFF, DFF, DFF}; pg8::SchedGrid S; S.to.init(T / 256, DM / 256); S.G = G; S.c = c; S.A = (const char*)(ws + WS_GATES); S.B = (const char*)(ws + WS_WDN); S.ta = (size_t)256 * DFF * 2; S.tb = (size_t)256 * DFF * 2;
            if constexpr (l + 1 < DEPTH) { pg8::EpiRes<true, true> E{(const void*)(ws + WS_X), (void*)(ws + WS_X)}; pg8::gemm_phase<pg8::EpiRes<true, true>, pg8::SchedGrid, true, true>(lds, g, S, E, wv0); }
            else { pg8::EpiRes<true, false> E{(const void*)(ws + WS_X), (void*)A.out()}; pg8::gemm_phase<pg8::EpiRes<true, false>, pg8::SchedGrid, true, true>(lds, g, S, E, wv0); }
        }
}

__global__ void __launch_bounds__(512, 2) fwd_megakernel(Args KA) {
    extern __shared__ __attribute__((aligned(16))) unsigned char lds_raw[];
    LAS unsigned char* lds = (LAS unsigned char*)lds_raw;
    const int wv0 = __builtin_amdgcn_readfirstlane(threadIdx.x >> 6);
    {
        LAS unsigned long long* tb = (LAS unsigned long long*)(lds + LDS_BYTES - 256);
        if (threadIdx.x == 0) {
            tb[0] = (unsigned long long)KA.in[0]; tb[1] = (unsigned long long)KA.in[1]; tb[2] = (unsigned long long)KA.in[2]; tb[3] = (unsigned long long)KA.in[3]; tb[4] = (unsigned long long)KA.in[4];
            tb[5] = (unsigned long long)KA.in[5]; tb[6] = (unsigned long long)KA.in[6]; tb[7] = (unsigned long long)KA.in[7]; tb[8] = (unsigned long long)KA.in[8]; tb[9] = (unsigned long long)KA.in[9];
            tb[10] = (unsigned long long)KA.in[10]; tb[11] = (unsigned long long)KA.in[11]; tb[12] = (unsigned long long)KA.in[12]; tb[13] = (unsigned long long)KA.in[13]; tb[14] = (unsigned long long)KA.in[14];
            tb[15] = (unsigned long long)KA.in[15]; tb[16] = (unsigned long long)KA.in[16]; tb[17] = (unsigned long long)KA.in[17]; tb[18] = (unsigned long long)KA.in[18]; tb[19] = (unsigned long long)KA.in[19];
            tb[20] = (unsigned long long)KA.out; tb[21] = (unsigned long long)KA.ws;
        }
        if (threadIdx.x < 2) ((LAS unsigned*)(lds + LDS_BYTES - 64))[threadIdx.x] = 0u;
        __syncthreads();
    }
    (void)xcd_barrier_post((unsigned*)(KA.ws + WS_CTL), (volatile LAS unsigned*)(lds + LDS_BYTES - 64), threadIdx.x == 0);
    Ptrs A; A.base = (unsigned)(size_t)(lds + LDS_BYTES - 256);
    layer_body<0>(A, lds, lds_raw, wv0);
    GBAR();
    layer_body<1>(A, lds, lds_raw, wv0);
}

extern "C" void kernel_launch(void* const* d_in, const int* in_sizes, int n_in, void* d_out, int out_size, void* d_ws, size_t ws_size, hipStream_t stream) {
    static int grid = 0;
    if (grid == 0) {
        if (n_in != 20 || in_sizes[0] != T * DM || out_size != T * DM || ws_size < WS_END) {
            fprintf(stderr, "kernel_launch: unexpected shapes (n_in %d, in0 %d, out %d, ws %zu need %zu)\n", n_in, n_in > 0 ? in_sizes[0] : -1, out_size, ws_size, (size_t)WS_END); grid = -1; return; }
        int dev = 0, cus = 0, per_cu = 0;
        (void)hipGetDevice(&dev); (void)hipDeviceGetAttribute(&cus, hipDeviceAttributeMultiprocessorCount, dev);
        if (hipFuncSetAttribute((const void*)fwd_megakernel, hipFuncAttributeMaxDynamicSharedMemorySize, LDS_BYTES) != hipSuccess) { fprintf(stderr, "kernel_launch: hipFuncSetAttribute failed\n"); grid = -1; return; }
        if (hipOccupancyMaxActiveBlocksPerMultiprocessor(&per_cu, (const void*)fwd_megakernel, 512, LDS_BYTES) != hipSuccess || per_cu < 1) { fprintf(stderr, "kernel_launch: occupancy query failed (%d)\n", per_cu); per_cu = 1; }
        (void)hipGetLastError();
        grid = cus * per_cu;
    }
    if (grid < 0) return;
    Args a{};
    for (int i = 0; i < 20; ++i) a.in[i] = (const float*)d_in[i];
    a.out = (float*)d_out; a.ws = (unsigned char*)d_ws;
    if (hipMemsetAsync((char*)d_ws + WS_CTL, 0, CTL_BYTES, stream) != hipSuccess) { fprintf(stderr, "kernel_launch: memset failed\n"); return; }
    void* args[] = {&a};
    hipError_t e = hipLaunchCooperativeKernel((const void*)fwd_megakernel, dim3(grid), dim3(512), args, LDS_BYTES, stream);
    if (e != hipSuccess) fprintf(stderr, "kernel_launch: cooperative launch failed: %s (grid %d)\n", hipGetErrorString(e), grid);
}
```

```cpp
#include <hip/hip_runtime.h>
#include <hip/hip_cooperative_groups.h>
#include <cstdio>
#include <cstdint>
namespace cg = cooperative_groups;

#define LAS __attribute__((address_space(3)))
typedef unsigned short bf16;
typedef short bf16x8 __attribute__((ext_vector_type(8)));
typedef short s16x4 __attribute__((ext_vector_type(4)));
typedef float f32x2 __attribute__((ext_vector_type(2)));
typedef float f32x4 __attribute__((ext_vector_type(4)));
typedef float f32x16 __attribute__((ext_vector_type(16)));
typedef unsigned u32x2 __attribute__((ext_vector_type(2)));
typedef unsigned u32x4 __attribute__((ext_vector_type(4)));

constexpr int T = 16384, DM = 2048, NMEM = 256, DFF = 5632, INW = 13328, NP = 13312, DEPTH = 2;
constexpr float EPS = 1e-6f;
constexpr float LOG2E = 1.4426950408889634f;

constexpr size_t MiB = 1u << 20;
constexpr size_t WS_WIN = 0;
constexpr size_t WS_WBR = 52 * MiB;
constexpr size_t WS_WO = 64 * MiB;
constexpr size_t WS_WGU = 72 * MiB;
constexpr size_t WS_WDN = 116 * MiB;
constexpr size_t WS_WMK = 138 * MiB;
constexpr size_t WS_H = 154 * MiB;
constexpr size_t WS_GQ = 218 * MiB;
constexpr size_t WS_GK = 234 * MiB;
constexpr size_t WS_GV = 250 * MiB;
constexpr size_t WS_GR = 282 * MiB;
constexpr size_t WS_SQ = 314 * MiB;
constexpr size_t WS_SK = 346 * MiB;
constexpr size_t WS_SV = 378 * MiB;
constexpr size_t WS_MQ = 410 * MiB;
constexpr size_t WS_GATES = 442 * MiB;
constexpr size_t WS_ABR = 634 * MiB;
constexpr size_t WS_GA1 = 730 * MiB;
constexpr size_t WS_DEC = 731 * MiB;
constexpr size_t WS_MEMKV = 732 * MiB;
constexpr size_t WS_HM = 736 * MiB;
constexpr size_t WS_KN = 738 * MiB;
constexpr size_t WS_VT = 739 * MiB;
constexpr size_t WS_CTL = 740 * MiB;
constexpr size_t CTL_BYTES = 16384;
constexpr size_t WS_X = 741 * MiB;
constexpr size_t WS_END = 805 * MiB;
constexpr int LDS_BYTES = 147456;

__device__ __forceinline__ unsigned f2bf(float f) { unsigned u = __builtin_bit_cast(unsigned, f); return (u + 0x7fffu + ((u >> 16) & 1u)) >> 16; }
__device__ __forceinline__ unsigned pk2(float lo, float hi) { return f2bf(lo) | (f2bf(hi) << 16); }
__device__ __forceinline__ float bf2f(unsigned short b) { return __builtin_bit_cast(float, ((unsigned)b) << 16); }
__device__ __forceinline__ float bflo(unsigned w) { return __builtin_bit_cast(float, w << 16); }
__device__ __forceinline__ float bfhi(unsigned w) { return __builtin_bit_cast(float, w & 0xffff0000u); }
__device__ __forceinline__ unsigned cvtpk(float lo, float hi) { unsigned r; asm volatile("v_cvt_pk_bf16_f32 %0, %1, %2" : "=v"(r) : "v"(lo), "v"(hi)); return r; }
template <int PAT> __device__ __forceinline__ float swz(float v) { return __builtin_bit_cast(float, __builtin_amdgcn_ds_swizzle(__builtin_bit_cast(int, v), PAT)); }
__device__ __forceinline__ float swap16_sum(float v) { return v + swz<0x401F>(v); }
__device__ __forceinline__ float swap32_sum(float v) {
    const unsigned u = __builtin_bit_cast(unsigned, v); auto r = __builtin_amdgcn_permlane32_swap(u, u, false, false);
    const bool hi = __builtin_amdgcn_mbcnt_lo(~0u, 0u) == 32u; return v + __builtin_bit_cast(float, hi ? r[0] : r[1]); }
template <int CTRL> __device__ __forceinline__ float dppf(float v) { return __builtin_bit_cast(float, __builtin_amdgcn_update_dpp(0, __builtin_bit_cast(int, v), CTRL, 0xf, 0xf, true)); }
__device__ __forceinline__ float red4(float v) { v += dppf<0xB1>(v); v += dppf<0x4E>(v); return v; }
__device__ __forceinline__ float red8(float v) { v = red4(v); v += dppf<0x141>(v); return v; }
__device__ __forceinline__ float red16(float v) { v = red8(v); v += dppf<0x140>(v); return v; }
__device__ __forceinline__ float red32(float v) { return swap16_sum(red16(v)); }
__device__ __forceinline__ float wave_sum(float v) { return swap32_sum(red32(v)); }
__device__ __forceinline__ int crow(int r, int hi) { return (r & 3) + 8 * (r >> 2) + 4 * hi; }
__device__ __forceinline__ int opaque_s(int x) { asm volatile("" : "+s"(x)); return x; }
__device__ __forceinline__ unsigned char* opaque_p(unsigned char* p) { __attribute__((address_space(1))) unsigned char* g = (__attribute__((address_space(1))) unsigned char*)p; asm volatile("" : "+s"(g)); return (unsigned char*)g; }
#define TID() (wv0 * 64 + (int)__builtin_amdgcn_mbcnt_hi(~0u, __builtin_amdgcn_mbcnt_lo(~0u, 0u)))
__device__ __forceinline__ int opaque(int x) { asm volatile("" : "+v"(x)); return x; }
#define LDS_WAIT() asm volatile("s_waitcnt lgkmcnt(0)" ::: "memory")
#define SBAR() __builtin_amdgcn_sched_barrier(0)

namespace pg8 {
#define PG8_LAS __attribute__((address_space(3)))
constexpr int BM = 256, BK = 64, HALF = 128, HTB = HALF * BK * 2, STAGE_BYTES = 8 * HTB, NXCD = 8, WGM = 4;
__host__ __device__ __forceinline__ int lds_byte(int r, int c) { const int st = (r >> 4) * 2 + (c >> 5), rr = r & 15, cc = c & 31, ob = rr * 64 + cc * 2; return st * 1024 + (ob ^ (((ob >> 9) & 1) << 5)); }
__host__ __device__ __forceinline__ void stage_rc(int b, int& R, int& C) { const int st = b / 1024, sb = b % 1024, swz = sb ^ (((sb >> 9) & 1) << 5); R = (st >> 1) * 16 + swz / 64; C = (st & 1) * 32 + (swz % 64) / 2; }
__host__ __device__ __forceinline__ int perm32(int rho) { const int n = rho >> 4, i = rho & 15; return 8 * (i >> 2) + 4 * n + (i & 3); }

struct Unit { int pm, pn, aux; const char* a; const char* b; };
struct Gemm { int K, lda, ldb; };

struct TileOrder {
    int nM, nN, nwg;
    __device__ __forceinline__ void init(int nM_, int nN_) { nM = nM_; nN = nN_; nwg = nM * nN; }
    __device__ __forceinline__ bool get(long L, int& pm, int& pn) const {
        if (L >= nwg) return false;
        int wgid = (int)L; { const int q = nwg / NXCD, r = nwg % NXCD, xcd = wgid % NXCD, off = wgid / NXCD; wgid = (xcd < r ? xcd * (q + 1) : r * (q + 1) + (xcd - r) * q) + off; }
        const int nig = WGM * nN, gid = wgid / nig, fm = gid * WGM, gsz = (nM - fm) < WGM ? (nM - fm) : WGM;
        pm = fm + ((wgid % nig) % gsz); pn = (wgid % nig) / gsz; return true;
    }
};
struct SchedGrid {
    TileOrder to; int G, c; const char* A; const char* B; size_t ta, tb;
    __device__ __forceinline__ bool next(int i, Unit& u) const { int pm, pn; if (!to.get((long)i * G + c, pm, pn)) return false; u.pm = pm; u.pn = pn; u.aux = 0; u.a = A + (size_t)pm * ta; u.b = B + (size_t)pn * tb; return true; }
};
struct SchedBranch {
    TileOrder to; int G, c; const char* A; const char* B;
    __device__ __forceinline__ bool next(int i, Unit& u) const { int pm, pn; const int tl = i / 3, br = i - tl * 3; if (!to.get((long)tl * G + c, pm, pn)) return false; u.pm = pm; u.pn = pn; u.aux = br;
        u.a = A + ((size_t)br * T + (size_t)pm * 256) * 1024 * 2; u.b = B + ((size_t)br * 2048 + (size_t)pn * 256) * 1024 * 2; return true; }
};
struct SchedOne {
    Unit one;
    __device__ __forceinline__ bool next(int i, Unit& u) const { if (i != 0) return false; u = one; return true; }
};

__device__ __forceinline__ float sigmoid_f(float x) { return __builtin_amdgcn_rcpf(1.0f + __builtin_amdgcn_exp2f(-x * LOG2E)); }

struct EpiProj {
    static constexpr bool PERM = true, AFTER_DRAIN = false;
    unsigned char* ws;
    __device__ __forceinline__ void operator()(const f32x4 (&acc)[2][2][4][2], const Unit& u, int wr, int wc, int fr, int fq) const {
        const int row0 = u.pm * BM + wr * 64 + fr; int colt = u.pn * BM; bf16* base; int ld; bool sg = false;
        if (colt < 512) { base = (bf16*)(ws + WS_GQ); ld = 512; }
        else if (colt < 1024) { base = (bf16*)(ws + WS_GK); ld = 512; colt -= 512; }
        else if (colt < 2048) { base = (bf16*)(ws + WS_GV); ld = 1024; colt -= 1024; }
        else if (colt < 3072) { base = (bf16*)(ws + WS_GR); ld = 1024; colt -= 2048; }
        else if (colt < 7168) { const int blk = (colt - 3072) >> 10; base = (bf16*)(ws + WS_SQ) + (size_t)blk * T * 1024; ld = 1024; colt = (colt - 3072) & 1023; }
        else { base = (bf16*)(ws + WS_GATES); ld = 6144; colt -= 7168; sg = true; }
        const int col0 = colt + wc * 32 + 8 * fq;
        if (sg) {
            const int tidx = ((wr * 4 + wc) * 64 + fq * 16 + fr);
            u32x2* gb = (u32x2*)(ws + WS_GATES) + ((size_t)(u.pm * 24 + (u.pn - 28)) * 16) * 512 + tidx;
#pragma unroll
            for (int ai = 0; ai < 2; ++ai)
#pragma unroll
                for (int m = 0; m < 4; ++m)
#pragma unroll
                    for (int bj = 0; bj < 2; ++bj) { const f32x4 v0 = acc[ai][bj][m][0], v1 = acc[ai][bj][m][1]; unsigned lo = 0u, hi = 0u;
#pragma unroll
                        for (int j = 0; j < 4; ++j) { lo |= max((unsigned)(sigmoid_f(v0[j]) * 255.0f + 0.5f), 1u) << (8 * j); hi |= max((unsigned)(sigmoid_f(v1[j]) * 255.0f + 0.5f), 1u) << (8 * j); }
                        u32x2 w; w.x = lo; w.y = hi; gb[(size_t)((ai * 4 + m) * 2 + bj) * 512] = w; }
            return;
        }
#pragma unroll
        for (int ai = 0; ai < 2; ++ai)
#pragma unroll
            for (int m = 0; m < 4; ++m) { bf16* rowp = base + (size_t)(row0 + ai * HALF + m * 16) * ld + col0;
#pragma unroll
                for (int bj = 0; bj < 2; ++bj) { f32x4 v0 = acc[ai][bj][m][0], v1 = acc[ai][bj][m][1];
                    if (sg) {
#pragma unroll
                        for (int j = 0; j < 4; ++j) { v0[j] = sigmoid_f(v0[j]); v1[j] = sigmoid_f(v1[j]); } }
                    u32x4 w; w.x = cvtpk(v0[0], v0[1]); w.y = cvtpk(v0[2], v0[3]); w.z = cvtpk(v1[0], v1[1]); w.w = cvtpk(v1[2], v1[3]);
                    *(u32x4*)(rowp + bj * HALF) = w; } }
    }
};
struct EpiBf16 {
    static constexpr bool PERM = true, AFTER_DRAIN = false;
    bf16* O; int ldc;
    __device__ __forceinline__ void operator()(const f32x4 (&acc)[2][2][4][2], const Unit& u, int wr, int wc, int fr, int fq) const {
        const int row0 = u.pm * BM + wr * 64 + fr; const int col0 = u.pn * BM + wc * 32 + 8 * fq;
#pragma unroll
        for (int ai = 0; ai < 2; ++ai)
#pragma unroll
            for (int m = 0; m < 4; ++m) { bf16* rowp = O + (size_t)(row0 + ai * HALF + m * 16) * ldc + col0;
#pragma unroll
                for (int bj = 0; bj < 2; ++bj) { const f32x4 v0 = acc[ai][bj][m][0], v1 = acc[ai][bj][m][1];
                    u32x4 w; w.x = cvtpk(v0[0], v0[1]); w.y = cvtpk(v0[2], v0[3]); w.z = cvtpk(v1[0], v1[1]); w.w = cvtpk(v1[2], v1[3]);
                    *(u32x4*)(rowp + bj * HALF) = w; } }
    }
};
struct EpiSwiglu {
    static constexpr bool PERM = true, AFTER_DRAIN = false;
    bf16* O;
    __device__ __forceinline__ void operator()(const f32x4 (&acc)[2][2][4][2], const Unit& u, int wr, int wc, int fr, int fq) const {
        const int row0 = u.pm * BM + wr * 64 + fr; const int col0 = u.pn * HALF + wc * 32 + 8 * fq;
#pragma unroll
        for (int ai = 0; ai < 2; ++ai)
#pragma unroll
            for (int m = 0; m < 4; ++m) { bf16* rowp = O + (size_t)(row0 + ai * HALF + m * 16) * DFF + col0;
                f32x4 g0 = acc[ai][0][m][0], g1 = acc[ai][0][m][1]; const f32x4 u0 = acc[ai][1][m][0], u1 = acc[ai][1][m][1];
#pragma unroll
                for (int j = 0; j < 4; ++j) { g0[j] = g0[j] * sigmoid_f(g0[j]) * u0[j]; g1[j] = g1[j] * sigmoid_f(g1[j]) * u1[j]; }
                u32x4 w; w.x = cvtpk(g0[0], g0[1]); w.y = cvtpk(g0[2], g0[3]); w.z = cvtpk(g1[0], g1[1]); w.w = cvtpk(g1[2], g1[3]);
                *(u32x4*)rowp = w; }
    }
};
struct EpiMerge {
    static constexpr bool PERM = true, AFTER_DRAIN = false, KEEP_ACC = true;
    const unsigned char* gates; bf16* mg;
    __device__ __forceinline__ void operator()(const f32x4 (&)[2][2][4][2], const Unit&, int, int, int, int) const {}
    __device__ __forceinline__ void mid(f32x4 (&acc)[2][2][4][2], const Unit& u, int wr, int wc, int fr, int fq) const {
        const int row0 = u.pm * BM + wr * 64 + fr; const int col0 = u.pn * BM + wc * 32 + 8 * fq; const int br = u.aux;
        const int tidx = (wr * 4 + wc) * 64 + fq * 16 + fr;
        const u32x2* gnum = (const u32x2*)gates + ((size_t)(u.pm * 24 + br * 8 + u.pn) * 16) * 512 + tidx;
        const u32x2* gden = (const u32x2*)gates + ((size_t)(u.pm * 24 + (br < 2 ? br + 1 : 2) * 8 + u.pn) * 16) * 512 + tidx;
#pragma unroll
        for (int ai = 0; ai < 2; ++ai) {
            u32x2 gn[8], gd[8];
#pragma unroll
            for (int q = 0; q < 8; ++q) { gn[q] = gnum[(size_t)(ai * 8 + q) * 512]; if (br < 2) gd[q] = gden[(size_t)(ai * 8 + q) * 512]; }
#pragma unroll
            for (int m = 0; m < 4; ++m)
#pragma unroll
                for (int bj = 0; bj < 2; ++bj) { const int q = m * 2 + bj; const u32x2 n = gn[q]; f32x4 s0, s1;
                    s0[0] = (float)(n.x & 0xffu); s0[1] = (float)((n.x >> 8) & 0xffu); s0[2] = (float)((n.x >> 16) & 0xffu); s0[3] = (float)(n.x >> 24);
                    s1[0] = (float)(n.y & 0xffu); s1[1] = (float)((n.y >> 8) & 0xffu); s1[2] = (float)((n.y >> 16) & 0xffu); s1[3] = (float)(n.y >> 24);
                    if (br < 2) { const u32x2 d = gd[q];
                        s0[0] *= __builtin_amdgcn_rcpf((float)(d.x & 0xffu)); s0[1] *= __builtin_amdgcn_rcpf((float)((d.x >> 8) & 0xffu)); s0[2] *= __builtin_amdgcn_rcpf((float)((d.x >> 16) & 0xffu)); s0[3] *= __builtin_amdgcn_rcpf((float)(d.x >> 24));
                        s1[0] *= __builtin_amdgcn_rcpf((float)(d.y & 0xffu)); s1[1] *= __builtin_amdgcn_rcpf((float)((d.y >> 8) & 0xffu)); s1[2] *= __builtin_amdgcn_rcpf((float)((d.y >> 16) & 0xffu)); s1[3] *= __builtin_amdgcn_rcpf((float)(d.y >> 24));
                        acc[ai][bj][m][0] *= s0; acc[ai][bj][m][1] *= s1;
                    } else { constexpr float I255 = 1.0f / 255.0f; const f32x4 v0 = acc[ai][bj][m][0] * s0 * I255, v1 = acc[ai][bj][m][1] * s1 * I255;
                        u32x4 w; w.x = cvtpk(v0[0], v0[1]); w.y = cvtpk(v0[2], v0[3]); w.z = cvtpk(v1[0], v1[1]); w.w = cvtpk(v1[2], v1[3]);
                        *(u32x4*)(mg + (size_t)(row0 + ai * HALF + m * 16) * 2048 + col0 + bj * HALF) = w;
                        acc[ai][bj][m][0] = (f32x4){0.f, 0.f, 0.f, 0.f}; acc[ai][bj][m][1] = (f32x4){0.f, 0.f, 0.f, 0.f}; } }
        }
    }
};
template <bool BASE_BF, bool OUT_BF>
struct EpiRes {
    static constexpr bool PERM = true, AFTER_DRAIN = false;
    const void* base; void* out;
    __device__ __forceinline__ void operator()(const f32x4 (&acc)[2][2][4][2], const Unit& u, int wr, int wc, int fr, int fq) const {
        const int row0 = u.pm * BM + wr * 64 + fr, col0 = u.pn * BM + wc * 32 + 8 * fq;
#pragma unroll
        for (int ai = 0; ai < 2; ++ai)
#pragma unroll
            for (int mp = 0; mp < 2; ++mp) {
                f32x4 b0[2][2], b1[2][2];
#pragma unroll
                for (int mm = 0; mm < 2; ++mm)
#pragma unroll
                    for (int bj = 0; bj < 2; ++bj) { const size_t off = (size_t)(row0 + ai * HALF + (2 * mp + mm) * 16) * 2048 + col0 + bj * HALF;
                        if (BASE_BF) { const u32x4 w = *(const u32x4*)((const bf16*)base + off);
                            b0[mm][bj] = (f32x4){bflo(w.x), bfhi(w.x), bflo(w.y), bfhi(w.y)}; b1[mm][bj] = (f32x4){bflo(w.z), bfhi(w.z), bflo(w.w), bfhi(w.w)}; }
                        else { b0[mm][bj] = __builtin_nontemporal_load((const f32x4*)((const float*)base + off)); b1[mm][bj] = __builtin_nontemporal_load((const f32x4*)((const float*)base + off + 4)); } }
#pragma unroll
                for (int mm = 0; mm < 2; ++mm)
#pragma unroll
                    for (int bj = 0; bj < 2; ++bj) { const int m = 2 * mp + mm; const size_t off = (size_t)(row0 + ai * HALF + m * 16) * 2048 + col0 + bj * HALF;
                        const f32x4 v0 = b0[mm][bj] + acc[ai][bj][m][0], v1 = b1[mm][bj] + acc[ai][bj][m][1];
                        if (OUT_BF) { u32x4 w; w.x = cvtpk(v0[0], v0[1]); w.y = cvtpk(v0[2], v0[3]); w.z = cvtpk(v1[0], v1[1]); w.w = cvtpk(v1[2], v1[3]); *(u32x4*)((bf16*)out + off) = w; }
                        else { *(f32x4*)((float*)out + off) = v0; *(f32x4*)((float*)out + off + 4) = v1; } }
            }
    }
};
struct EpiSoftmax {
    static constexpr bool PERM = true, AFTER_DRAIN = true;
    bf16* P;
    __device__ __forceinline__ void operator()(const f32x4 (&)[2][2][4][2], const Unit&, int, int, int, int) const {}
    __device__ __forceinline__ void fused(f32x4 (&acc)[2][2][4][2], const Unit& u, int wr, int wc, int fr, int fq, PG8_LAS unsigned char* lds, int wid, int lane) const {
        PG8_LAS float* S = (PG8_LAS float*)lds;
#pragma unroll
        for (int ai = 0; ai < 2; ++ai)
#pragma unroll
            for (int m = 0; m < 4; ++m) { float s = 0.f;
#pragma unroll
                for (int bj = 0; bj < 2; ++bj)
#pragma unroll
                    for (int n = 0; n < 2; ++n) { f32x4 x = acc[ai][bj][m][n];
#pragma unroll
                        for (int j = 0; j < 4; ++j) x[j] = __builtin_amdgcn_exp2f(x[j]);
                        acc[ai][bj][m][n] = x; s += (x[0] + x[1]) + (x[2] + x[3]); }
                s = swap32_sum(swap16_sum(s));
                if (fq == 0) S[(ai * HALF + wr * 64 + m * 16 + fr) * 4 + wc] = s; }
        asm volatile("s_waitcnt lgkmcnt(0)" ::: "memory"); __builtin_amdgcn_s_barrier(); asm volatile("" ::: "memory");
        const int row0 = u.pm * BM + wr * 64 + fr; const int col0 = u.pn * BM + wc * 32 + 8 * fq;
#pragma unroll
        for (int ai = 0; ai < 2; ++ai)
#pragma unroll
            for (int m = 0; m < 4; ++m) { const int rl = ai * HALF + wr * 64 + m * 16 + fr; const f32x4 pp = *(const PG8_LAS f32x4*)(S + rl * 4);
                const float rinv = 1.0f / ((pp[0] + pp[1]) + (pp[2] + pp[3]));
                bf16* rowp = P + (size_t)(row0 + ai * HALF + m * 16) * 1024 + col0;
#pragma unroll
                for (int bj = 0; bj < 2; ++bj) { const f32x4 v0 = acc[ai][bj][m][0] * rinv, v1 = acc[ai][bj][m][1] * rinv;
                    u32x4 w; w.x = cvtpk(v0[0], v0[1]); w.y = cvtpk(v0[2], v0[3]); w.z = cvtpk(v1[0], v1[1]); w.w = cvtpk(v1[2], v1[3]);
                    *(u32x4*)(rowp + bj * HALF) = w; } }
    }
};

template <class E, class = void> struct epi_keeps_acc { static constexpr bool value = false; };
template <class E> struct epi_keeps_acc<E, decltype((void)E::KEEP_ACC)> { static constexpr bool value = E::KEEP_ACC; };
template <class Epi, class Sched, bool ALIGN_EPI = false, bool SP2 = false>
__device__ __forceinline__ void gemm_phase(PG8_LAS unsigned char* lds, const Gemm g, const Sched& S, const Epi& E, const int wv0) {
    const int tid = opaque(TID()), wid = __builtin_amdgcn_readfirstlane(tid >> 6), lane = tid & 63, wr = wid >> 2, wc = wid & 3, fr = lane & 15, fq = lane >> 4;
    const int K = g.K, nt = K / BK;
    unsigned voffA[2], voffB[2];
#pragma unroll
    for (int i = 0; i < 2; ++i) { int R, C; stage_rc(tid * 16 + i * 8192, R, C); const int Rb = Epi::PERM ? ((R & ~31) + perm32(R & 31)) : R;
        voffA[i] = (unsigned)(R * g.lda + C) * 2u; voffB[i] = (unsigned)(Rb * g.ldb + C) * 2u; }
    const size_t kstep = (size_t)(BK * 2);
    const size_t hstepA = (size_t)HALF * g.lda * 2, hstepB = (size_t)HALF * g.ldb * 2;
    const unsigned ldsw = (unsigned)wid * 1024u;
    const int aoff = lds_byte(wr * 64 + fr, fq * 8), boff = lds_byte(wc * 32 + fr, fq * 8);
#define PG8_SA(b, h) (((b) * 2 + (h)) * HTB)
#define PG8_SB(b, h) ((4 + (b) * 2 + (h)) * HTB)
#define PG8_STAGE(bufoff, gbase, voff) do { _Pragma("unroll") for (int _i = 0; _i < 2; ++_i) \
        __builtin_amdgcn_global_load_lds((const unsigned*)((const char*)(gbase) + (voff)[_i]), (PG8_LAS unsigned*)(lds + (bufoff) + ldsw + _i * 8192), 16, 0, 0); } while (0)
#define PG8_LDA(dst, b, h) do { _Pragma("unroll") for (int m = 0; m < 4; ++m) _Pragma("unroll") for (int k = 0; k < 2; ++k) dst[m][k] = *(const PG8_LAS bf16x8*)(lds + PG8_SA(b, h) + aoff + m * 2048 + k * 1024); } while (0)
#define PG8_LDB(dst, b, h) do { _Pragma("unroll") for (int n = 0; n < 2; ++n) _Pragma("unroll") for (int k = 0; k < 2; ++k) dst[n][k] = *(const PG8_LAS bf16x8*)(lds + PG8_SB(b, h) + boff + n * 2048 + k * 1024); } while (0)
#define PG8_MMA(ai, bj, At, Bt) do { __builtin_amdgcn_s_setprio(1); _Pragma("unroll") for (int m = 0; m < 4; ++m) _Pragma("unroll") for (int n = 0; n < 2; ++n) _Pragma("unroll") for (int k = 0; k < 2; ++k) \
        acc[ai][bj][m][n] = __builtin_amdgcn_mfma_f32_16x16x32_bf16(Bt[n][k], At[m][k], acc[ai][bj][m][n], 0, 0, 0); __builtin_amdgcn_s_setprio(0); } while (0)
#define PG8_WAIT_V(n) asm volatile("s_waitcnt vmcnt(" #n ")" ::: "memory")
#define PG8_WAIT_L(n) asm volatile("s_waitcnt lgkmcnt(" #n ")" ::: "memory")
#define PG8_BAR __builtin_amdgcn_s_barrier()
#define PG8_SCHED __builtin_amdgcn_sched_barrier(0)
    Unit cur, nxt; int ui = 0;
    if (!S.next(0, cur)) return;
    f32x4 acc[2][2][4][2];
#pragma unroll
    for (int a = 0; a < 2; ++a)
#pragma unroll
        for (int b = 0; b < 2; ++b)
#pragma unroll
            for (int m = 0; m < 4; ++m)
#pragma unroll
                for (int n = 0; n < 2; ++n) acc[a][b][m][n] = (f32x4){0.f, 0.f, 0.f, 0.f};
    bf16x8 At[4][2], B0[2][2], B1[2][2];
    const char* cA = cur.a; const char* cB = cur.b;
    if constexpr (SP2) {
        PG8_STAGE(PG8_SB(0, 0), cB, voffB); PG8_STAGE(PG8_SB(0, 1), cB + hstepB, voffB); PG8_STAGE(PG8_SA(0, 0), cA, voffA); PG8_STAGE(PG8_SA(0, 1), cA + hstepA, voffA);
        if (wr == 1) PG8_BAR;
        PG8_WAIT_V(2); PG8_BAR;
        PG8_STAGE(PG8_SB(1, 0), cB + kstep, voffB); PG8_STAGE(PG8_SA(1, 0), cA + kstep, voffA); PG8_STAGE(PG8_SB(1, 1), cB + hstepB + kstep, voffB);
        PG8_WAIT_V(6); PG8_BAR;
    } else {
        PG8_STAGE(PG8_SB(0, 0), cB, voffB); PG8_STAGE(PG8_SA(0, 0), cA, voffA); PG8_STAGE(PG8_SB(0, 1), cB + hstepB, voffB); PG8_STAGE(PG8_SA(0, 1), cA + hstepA, voffA);
        if (wr == 1) PG8_BAR;
        PG8_WAIT_V(4); PG8_BAR;
        PG8_STAGE(PG8_SB(1, 0), cB + kstep, voffB); PG8_STAGE(PG8_SA(1, 0), cA + kstep, voffA); PG8_STAGE(PG8_SB(1, 1), cB + hstepB + kstep, voffB);
        PG8_WAIT_V(6); PG8_BAR;
    }
    for (;;) {
        const bool has_next = S.next(ui + 1, nxt);
        const char* nA = has_next ? nxt.a : cA; const char* nB = has_next ? nxt.b : cB;
        for (int t = 0; t < nt; t += 2) {
            const bool last = (t == nt - 2);
            const char* a1 = cA + (size_t)(t + 1) * kstep;
            const char* a2 = last ? nA : cA + (size_t)(t + 2) * kstep; const char* b2 = last ? nB : cB + (size_t)(t + 2) * kstep;
            const char* a3 = a2 + kstep; const char* b3 = b2 + kstep;
            if constexpr (SP2) {
            PG8_LDB(B0, 0, 0); PG8_LDB(B1, 0, 1); PG8_SCHED; PG8_LDA(At, 0, 0); PG8_STAGE(PG8_SA(1, 1), a1 + hstepA, voffA);
            PG8_WAIT_V(8); PG8_WAIT_L(0); PG8_BAR; PG8_MMA(0, 0, At, B0); PG8_MMA(0, 1, At, B1); PG8_BAR; PG8_SCHED;
            PG8_LDA(At, 0, 1); PG8_STAGE(PG8_SB(0, 0), b2, voffB); PG8_STAGE(PG8_SB(0, 1), b2 + hstepB, voffB); PG8_STAGE(PG8_SA(0, 0), a2, voffA);
            PG8_WAIT_V(8); PG8_WAIT_L(0); PG8_BAR; PG8_MMA(1, 0, At, B0); PG8_MMA(1, 1, At, B1); PG8_BAR; PG8_SCHED;
            PG8_LDB(B0, 1, 0); PG8_LDB(B1, 1, 1); PG8_SCHED; PG8_LDA(At, 1, 0); PG8_STAGE(PG8_SA(0, 1), a2 + hstepA, voffA);
            PG8_WAIT_V(8); PG8_WAIT_L(0); PG8_BAR; PG8_MMA(0, 0, At, B0); PG8_MMA(0, 1, At, B1); PG8_BAR; PG8_SCHED;
            PG8_LDA(At, 1, 1); PG8_STAGE(PG8_SB(1, 0), b3, voffB); PG8_STAGE(PG8_SB(1, 1), b3 + hstepB, voffB); PG8_STAGE(PG8_SA(1, 0), a3, voffA);
            PG8_WAIT_V(8); PG8_WAIT_L(0); PG8_BAR; PG8_MMA(1, 0, At, B0); PG8_MMA(1, 1, At, B1); PG8_BAR; PG8_SCHED;
            } else {
            PG8_LDB(B0, 0, 0); PG8_SCHED; PG8_LDA(At, 0, 0); PG8_STAGE(PG8_SA(1, 1), a1 + hstepA, voffA);
            PG8_WAIT_L(8); PG8_BAR; PG8_WAIT_L(0); PG8_MMA(0, 0, At, B0); PG8_BAR; PG8_SCHED;
            PG8_LDB(B1, 0, 1); PG8_STAGE(PG8_SB(0, 0), b2, voffB);
            PG8_BAR; PG8_WAIT_L(0); PG8_MMA(0, 1, At, B1); PG8_BAR;
            PG8_LDA(At, 0, 1); PG8_STAGE(PG8_SA(0, 0), a2, voffA);
            PG8_BAR; PG8_WAIT_L(0); PG8_MMA(1, 0, At, B0); PG8_BAR; PG8_SCHED;
            PG8_STAGE(PG8_SB(0, 1), b2 + hstepB, voffB);
            PG8_WAIT_V(6); PG8_BAR; PG8_MMA(1, 1, At, B1); PG8_BAR;
            PG8_LDB(B0, 1, 0); PG8_SCHED; PG8_LDA(At, 1, 0); PG8_STAGE(PG8_SA(0, 1), a2 + hstepA, voffA);
            PG8_WAIT_L(8); PG8_BAR; PG8_WAIT_L(0); PG8_MMA(0, 0, At, B0); PG8_BAR; PG8_SCHED;
            PG8_LDB(B1, 1, 1); PG8_STAGE(PG8_SB(1, 0), b3, voffB);
            PG8_BAR; PG8_WAIT_L(0); PG8_MMA(0, 1, At, B1); PG8_BAR;
            PG8_LDA(At, 1, 1); PG8_STAGE(PG8_SA(1, 0), a3, voffA);
            PG8_BAR; PG8_WAIT_L(0); PG8_MMA(1, 0, At, B0); PG8_BAR; PG8_SCHED;
            PG8_STAGE(PG8_SB(1, 1), b3 + hstepB, voffB);
            PG8_WAIT_V(6); PG8_BAR; PG8_MMA(1, 1, At, B1); PG8_BAR;
            }
        }
        if constexpr (ALIGN_EPI) { if (wr == 0) PG8_BAR; }
        if constexpr (epi_keeps_acc<Epi>::value) { E.mid(acc, cur, wr, wc, fr, fq); } else if constexpr (!Epi::AFTER_DRAIN) { E(acc, cur, wr, wc, fr, fq); }
        if (!has_next) break;
        if constexpr (!epi_keeps_acc<Epi>::value) {
#pragma unroll
        for (int a = 0; a < 2; ++a)
#pragma unroll
            for (int b = 0; b < 2; ++b)
#pragma unroll
                for (int m = 0; m < 4; ++m)
#pragma unroll
                    for (int n = 0; n < 2; ++n) acc[a][b][m][n] = (f32x4){0.f, 0.f, 0.f, 0.f};
        }
        cur = nxt; cA = nA; cB = nB; ++ui;
        if constexpr (ALIGN_EPI) { if (wr == 1) PG8_BAR; }
    }
    PG8_WAIT_V(0);
    if constexpr (!ALIGN_EPI) { if (wr == 0) PG8_BAR; }
    PG8_BAR;
    if constexpr (Epi::AFTER_DRAIN) { E.fused(acc, cur, wr, wc, fr, fq, lds, wid, lane); }
#undef PG8_SA
#undef PG8_SB
#undef PG8_STAGE
#undef PG8_LDA
#undef PG8_LDB
#undef PG8_MMA
#undef PG8_WAIT_V
#undef PG8_WAIT_L
#undef PG8_BAR
#undef PG8_SCHED
}
}

namespace sba {
constexpr int KVBLK = 64, LD = 1024;
constexpr size_t SHM_V = KVBLK * 128 * 2, SHM_K = KVBLK * 128 * 2;
#define KSWZ(row, colB) ((row) * 256 + ((colB) ^ (((row) & 7) << 4)))
__device__ __forceinline__ void qkt(f32x16& p0, f32x16& p1, const char* Ks, const bf16x8* qr, int r32, int hi) {
    p0 = f32x16{}; p1 = f32x16{};
#pragma unroll
    for (int d0 = 0; d0 < 8; ++d0) { const int cb = (d0 * 16 + hi * 8) * 2;
        const bf16x8 b0 = *reinterpret_cast<const bf16x8*>(Ks + KSWZ(r32, cb));
        const bf16x8 b1 = *reinterpret_cast<const bf16x8*>(Ks + KSWZ(32 + r32, cb));
        p0 = __builtin_amdgcn_mfma_f32_32x32x16_bf16(b0, qr[d0], p0, 0, 0, 0);
        p1 = __builtin_amdgcn_mfma_f32_32x32x16_bf16(b1, qr[d0], p1, 0, 0, 0); }
}
__device__ __forceinline__ int v_st(int k, int c) { const int kk = (k & ~0xC) | ((k & 4) << 1) | ((k & 8) >> 1); return ((kk >> 3) * 4 + (c >> 5)) * 512 + ((kk & 7) * 32 + (c & 31)) * 2; }
__device__ __forceinline__ int v_rd_base(int lane) { return ((lane & 3) << 3) | (((lane >> 2) & 3) << 6) | (((lane >> 4) & 1) << 5) | (((lane >> 5) & 1) << 8); }
constexpr int v_rd_off(int d0, int ks, int half) { return d0 * 512 + ks * 4096 + half * 2048; }
template <int OFF> __device__ __forceinline__ s16x4 tr_read(int vb) {
    s16x4 r; asm volatile("ds_read_b64_tr_b16 %0, %1 offset:%2" : "=&v"(r) : "v"(vb), "i"(OFF) : "memory"); return r;
}
template <int D0> __device__ __forceinline__ void pv_one(f32x16& od, int vb, bf16x8 pa0, bf16x8 pa1, bf16x8 pa2, bf16x8 pa3) {
    const s16x4 l0 = tr_read<v_rd_off(D0, 0, 0)>(vb), h0 = tr_read<v_rd_off(D0, 0, 1)>(vb), l1 = tr_read<v_rd_off(D0, 1, 0)>(vb), h1 = tr_read<v_rd_off(D0, 1, 1)>(vb);
    const s16x4 l2 = tr_read<v_rd_off(D0, 2, 0)>(vb), h2 = tr_read<v_rd_off(D0, 2, 1)>(vb), l3 = tr_read<v_rd_off(D0, 3, 0)>(vb), h3 = tr_read<v_rd_off(D0, 3, 1)>(vb);
    asm volatile("s_waitcnt lgkmcnt(0)" ::: "memory"); SBAR();
#define PK(L, H) (bf16x8){L[0], L[1], L[2], L[3], H[0], H[1], H[2], H[3]}
    od = __builtin_amdgcn_mfma_f32_32x32x16_bf16(pa0, PK(l0, h0), od, 0, 0, 0);
    od = __builtin_amdgcn_mfma_f32_32x32x16_bf16(pa1, PK(l1, h1), od, 0, 0, 0);
    od = __builtin_amdgcn_mfma_f32_32x32x16_bf16(pa2, PK(l2, h2), od, 0, 0, 0);
    od = __builtin_amdgcn_mfma_f32_32x32x16_bf16(pa3, PK(l3, h3), od, 0, 0, 0);
#undef PK
}
__device__ __forceinline__ void pv_d0(f32x16* o, int vb, bf16x8 pa0, bf16x8 pa1, bf16x8 pa2, bf16x8 pa3) {
    pv_one<0>(o[0], vb, pa0, pa1, pa2, pa3); pv_one<1>(o[1], vb, pa0, pa1, pa2, pa3); pv_one<2>(o[2], vb, pa0, pa1, pa2, pa3); pv_one<3>(o[3], vb, pa0, pa1, pa2, pa3);
}
__device__ __forceinline__ void sb_half(f32x16& p, float& carry, bool masked, int krow0, int tq, int hi) {
    float G[4];
#pragma unroll
    for (int g = 0; g < 4; ++g) {
        float q[4];
#pragma unroll
        for (int i = 0; i < 4; ++i) { const int r = 4 * g + i; const float e = __builtin_amdgcn_exp2f(p[r]); float qq = __builtin_amdgcn_rcpf(1.0f + e); float b = e * qq;
            if (masked) { const bool keep = (krow0 + crow(r, hi)) < tq; qq = keep ? qq : 1.0f; b = keep ? b : 0.0f; }
            q[i] = qq; p[r] = b; }
        const float s2 = q[3] * q[2], s1 = s2 * q[1]; G[g] = s1 * q[0];
        p[4 * g + 2] *= q[3]; p[4 * g + 1] *= s2; p[4 * g] *= s1;
    }
    float run = carry;
#pragma unroll
    for (int g = 3; g >= 0; --g) { const unsigned gu = __builtin_bit_cast(unsigned, G[g]); auto sw = __builtin_amdgcn_permlane32_swap(gu, gu, false, false);
        const float partner = __builtin_bit_cast(float, hi ? sw[0] : sw[1]);
        const float base = hi ? run : run * partner;
        p[4 * g] *= base; p[4 * g + 1] *= base; p[4 * g + 2] *= base; p[4 * g + 3] *= base; run *= G[g] * partner; }
    carry = run;
}
__device__ __forceinline__ void pack_p(const f32x16& p0, const f32x16& p1, bf16x8& pa0, bf16x8& pa1, bf16x8& pa2, bf16x8& pa3) {
#define PK4(P, BASE, OUT) do { unsigned a0 = cvtpk(P[BASE + 0], P[BASE + 1]), a1 = cvtpk(P[BASE + 2], P[BASE + 3]);   \
    unsigned b0 = cvtpk(P[BASE + 4], P[BASE + 5]), b1 = cvtpk(P[BASE + 6], P[BASE + 7]);                              \
    auto r0 = __builtin_amdgcn_permlane32_swap(a0, b0, false, false); auto r1 = __builtin_amdgcn_permlane32_swap(a1, b1, false, false); \
    u32x4 w = {r0[0], r1[0], r0[1], r1[1]}; OUT = *reinterpret_cast<bf16x8*>(&w); } while (0)
    PK4(p0, 0, pa0); PK4(p0, 8, pa1); PK4(p1, 0, pa2); PK4(p1, 8, pa3);
#undef PK4
}
__device__ __forceinline__ void sb_unit(const bf16* __restrict__ Qb, const bf16* __restrict__ Kh, const bf16* __restrict__ Vh, bf16* __restrict__ Ob, int q0, char* lds, const int wv0) {
    const int tid = opaque(TID()), wid = tid >> 6, lane = tid & 63, r32 = lane & 31, hi = lane >> 5;
    char* V_lds = lds; char* K_lds = lds + 2 * SHM_V;
    const int NT = (q0 + 256) / KVBLK;
    f32x16 o[4] = {}; bf16x8 qr[8];
    const int tq = q0 + wid * 32 + r32;
    const bf16* Qw = Qb + (size_t)tq * LD + hi * 8;
#pragma unroll
    for (int d0 = 0; d0 < 8; ++d0) qr[d0] = *reinterpret_cast<const bf16x8*>(Qw + d0 * 16);
    const int sr = tid >> 4, sc = (tid & 15) * 8, vst0 = v_st(sr, sc), vst1 = v_st(32 + sr, sc);
    const int vb0 = (int)(uintptr_t)V_lds + v_rd_base(lane);
    struct { bf16x8 vs0, vs1, ks0, ks1; } sr_[1];
#define K0(i) ((NT - 1 - (i)) * KVBLK)
#define SLOAD(i, k0) do { sr_[i].vs0 = *reinterpret_cast<const bf16x8*>(&Vh[(size_t)((k0) + sr) * LD + sc]); sr_[i].vs1 = *reinterpret_cast<const bf16x8*>(&Vh[(size_t)((k0) + 32 + sr) * LD + sc]); \
    sr_[i].ks0 = *reinterpret_cast<const bf16x8*>(&Kh[(size_t)((k0) + sr) * LD + sc]); sr_[i].ks1 = *reinterpret_cast<const bf16x8*>(&Kh[(size_t)((k0) + 32 + sr) * LD + sc]); } while (0)
#define SWRITE(b, i) do { *(bf16x8*)(V_lds + (b) * SHM_V + vst0) = sr_[i].vs0; *(bf16x8*)(V_lds + (b) * SHM_V + vst1) = sr_[i].vs1; const int kc = sc * 2; \
    *(bf16x8*)(K_lds + (b) * SHM_K + KSWZ(sr, kc)) = sr_[i].ks0; *(bf16x8*)(K_lds + (b) * SHM_K + KSWZ(32 + sr, kc)) = sr_[i].ks1; } while (0)
#define SWAIT() asm volatile("s_waitcnt vmcnt(0)" ::: "memory")
    f32x16 pA0, pA1, pB0, pB1; bf16x8 pa0, pa1, pa2, pa3; float carry = 1.0f;
    constexpr int SE = 0, SO = 0;
    __syncthreads();
    SLOAD(SE, K0(0)); asm volatile("s_waitcnt vmcnt(0)" ::: "memory"); SWRITE(0, SE); __syncthreads();
    qkt(pA0, pA1, K_lds, qr, r32, hi); sb_half(pA1, carry, true, K0(0) + 32, tq, hi);
    SLOAD(SO, K0(1));
    SWAIT(); SWRITE(1, SO); __syncthreads();
    volatile unsigned* votes = (volatile unsigned*)(lds + 4 * SHM_V);
    bool done = false;
    for (int j = 1; j + 1 < NT; j += 2) {
        SBAR(); qkt(pB0, pB1, K_lds + SHM_K, qr, r32, hi);
        sb_half(pA0, carry, (j - 1) < 4, K0(j - 1), tq, hi); pack_p(pA0, pA1, pa0, pa1, pa2, pa3); SBAR();
        { const int z = __all(carry == 0.0f); if (lane == 0) votes[wid] = (unsigned)z; }
        SLOAD(SO, K0(j + 1)); SBAR();
        pv_d0(o, vb0, pa0, pa1, pa2, pa3); sb_half(pB1, carry, j < 4, K0(j) + 32, tq, hi);
        __syncthreads();
        { unsigned a = 1u;
#pragma unroll
          for (int w = 0; w < 8; ++w) a &= votes[w];
          if (a) { done = true; break; } }
        SWAIT(); SWRITE(0, SE);
        __syncthreads();
        SBAR(); qkt(pA0, pA1, K_lds, qr, r32, hi);
        sb_half(pB0, carry, j < 4, K0(j), tq, hi); pack_p(pB0, pB1, pa0, pa1, pa2, pa3); SBAR();
        { const int z = __all(carry == 0.0f); if (lane == 0) votes[8 + wid] = (unsigned)z; }
        SLOAD(SE, K0(j + 2)); SBAR();
        pv_d0(o, vb0 + (int)SHM_V, pa0, pa1, pa2, pa3); sb_half(pA1, carry, (j + 1) < 4, K0(j + 1) + 32, tq, hi);
        __syncthreads();
        { unsigned a = 1u;
#pragma unroll
          for (int w = 0; w < 8; ++w) a &= votes[8 + w];
          if (a) { done = true; break; } }
        SWAIT(); SWRITE(1, SO);
        __syncthreads();
    }
    if (!done) {
        SBAR(); qkt(pB0, pB1, K_lds + SHM_K, qr, r32, hi);
        sb_half(pA0, carry, (NT - 2) < 4, K0(NT - 2), tq, hi); pack_p(pA0, pA1, pa0, pa1, pa2, pa3); SBAR();
        pv_d0(o, vb0, pa0, pa1, pa2, pa3); sb_half(pB1, carry, (NT - 1) < 4, K0(NT - 1) + 32, tq, hi);
        sb_half(pB0, carry, (NT - 1) < 4, K0(NT - 1), tq, hi); pack_p(pB0, pB1, pa0, pa1, pa2, pa3); SBAR();
        pv_d0(o, vb0 + (int)SHM_V, pa0, pa1, pa2, pa3);
    }
    bf16* Ow = Ob + (size_t)(q0 + wid * 32) * LD;
#pragma unroll
    for (int r = 0; r < 16; ++r) { const int orow = crow(r, hi);
#pragma unroll
        for (int d0 = 0; d0 < 4; ++d0) Ow[(size_t)orow * LD + d0 * 32 + r32] = (bf16)f2bf(o[d0][r]); }
#undef K0
#undef SLOAD
#undef SWRITE
#undef SWAIT
}
}

#define XB_TMO      128
#define XB_XCNT(j)  (256  + 64 * (j))
#define XB_XSUB(j)  (1280 + 64 * (j))
#define XB_XGEN(j)  (2304 + 64 * (j))
#define XB_TOP      3328
#define XB_TOPGEN   3392
#define XCD_BAR_WORDS 3456
#define XB_SPIN_CAP (1u << 18)

__device__ __forceinline__ unsigned xb_ld(unsigned* p)              { return __hip_atomic_load(p, __ATOMIC_RELAXED, __HIP_MEMORY_SCOPE_AGENT); }
__device__ __forceinline__ unsigned xb_add(unsigned* p, unsigned v) { return __hip_atomic_fetch_add(p, v, __ATOMIC_RELAXED, __HIP_MEMORY_SCOPE_AGENT); }
__device__ __forceinline__ unsigned xb_xcc_id() { return (unsigned)__builtin_amdgcn_s_getreg((3 << 11) | 20) & 0xFu; }
#define XB_SPIN(cond, bar) do { unsigned _sp = 0; while (cond) { __builtin_amdgcn_s_sleep(1); \
    if ((++_sp & 255u) == 0u) { if (xb_ld(&(bar)[XB_TMO])) break; if (_sp > XB_SPIN_CAP) { atomicAdd(&(bar)[XB_TMO], 1u); break; } } } } while (0)

struct XcdBarrier {
    unsigned* bar; unsigned x;
    volatile LAS unsigned* st;
};

__device__ __forceinline__ XcdBarrier xcd_barrier_post(unsigned* bar, volatile LAS unsigned* st, const bool TID0) {
    XcdBarrier b; b.bar = bar; b.x = xb_xcc_id(); b.st = st;
    if (TID0) (void)xb_add(&bar[XB_XCNT(b.x)], 1u);
    return b;
}
__device__ __forceinline__ void xcd_barrier_complete(unsigned* bar, unsigned x, unsigned& nloc, unsigned& nx) {
    const unsigned G = gridDim.x * gridDim.y * gridDim.z;
    unsigned sum, cnt, mine, sp = 0u;
    for (;;) {
        sum = 0u; cnt = 0u; mine = 0u;
#pragma unroll
        for (unsigned j = 0; j < 16; ++j) { const unsigned c = xb_ld(&bar[XB_XCNT(j)]); sum += c; cnt += (c > 0u) ? 1u : 0u; mine = (j == x) ? c : mine; }
        if (sum == G) break;
        __builtin_amdgcn_s_sleep(1);
        if ((++sp & 255u) == 0u) { if (xb_ld(&bar[XB_TMO])) break; if (sp > XB_SPIN_CAP) { atomicAdd(&bar[XB_TMO], 1u); break; } }
    }
    nloc = mine > 0u ? mine : 1u; nx = cnt > 0u ? cnt : 1u;
}

__device__ __forceinline__ void xcd_barrier(const XcdBarrier& b, const int wv0) {
    const bool TID0 = (opaque(TID()) == 0);
    asm volatile("s_waitcnt vmcnt(0)" ::: "memory");
    __syncthreads();
    if (TID0) {
        unsigned* bar = b.bar;
        __builtin_amdgcn_s_waitcnt(0);
        unsigned nloc = b.st[0], nx = b.st[1];
        if (nloc == 0u) { xcd_barrier_complete(bar, b.x, nloc, nx); b.st[0] = nloc; b.st[1] = nx; }
        const unsigned old = xb_add(&bar[XB_XSUB(b.x)], 1u);
        const unsigned gen = old / nloc;
        if (old + 1u == (gen + 1u) * nloc) {
            __builtin_amdgcn_fence(__ATOMIC_RELEASE, "agent");
            asm volatile("s_waitcnt vmcnt(0)" ::: "memory");
            const unsigned og = xb_add(&bar[XB_TOP], 1u);
            const unsigned tg = og / nx;
            if (og + 1u == (tg + 1u) * nx) xb_add(&bar[XB_TOPGEN], 1u);
            else XB_SPIN(xb_ld(&bar[XB_TOPGEN]) == tg, bar);
            __builtin_amdgcn_fence(__ATOMIC_ACQUIRE, "agent");
            xb_add(&bar[XB_XGEN(b.x)], 1u);
            asm volatile("s_waitcnt vmcnt(0)" ::: "memory");
        } else {
            XB_SPIN(xb_ld(&bar[XB_XGEN(b.x)]) == gen, bar);
            __builtin_amdgcn_fence(__ATOMIC_ACQUIRE, "agent");
            asm volatile("s_waitcnt vmcnt(0)" ::: "memory");
        }
    }
    __syncthreads();
}


struct Args { const float* in[20]; float* out; unsigned char* ws; };
struct Ptrs {
    unsigned base;
    __device__ __forceinline__ unsigned long long get(int k) const { unsigned a; asm volatile("v_mov_b32 %0, %1" : "=v"(a) : "s"(base)); const unsigned long long v = *(const LAS unsigned long long*)(a + 8u * (unsigned)k);
        const unsigned lo = __builtin_amdgcn_readfirstlane((unsigned)v), hi = __builtin_amdgcn_readfirstlane((unsigned)(v >> 32)); return ((unsigned long long)hi << 32) | lo; }
    __device__ __forceinline__ const float* in(int k) const { return (const float*)(const __attribute__((address_space(1))) float*)get(k); }
    __device__ __forceinline__ float* out() const { return (float*)(__attribute__((address_space(1))) float*)get(20); }
    __device__ __forceinline__ unsigned char* ws() const { return (unsigned char*)(__attribute__((address_space(1))) unsigned char*)get(21); }
};

__device__ __forceinline__ void transpose_item(const float* W, int ldw, int src_n0, int k0, bf16* WT, int K, int dst_n0, LAS float* scr, int lane) {
    float tv[32];
#pragma unroll
    for (int i = 0; i < 32; ++i) { const int kk = 2 * i + (lane >> 5); tv[i] = __builtin_nontemporal_load(&W[(size_t)(k0 + kk) * ldw + src_n0 + (lane & 31)]); }
#pragma unroll
    for (int i = 0; i < 32; ++i) { const int kk = 2 * i + (lane >> 5); scr[kk * 33 + (lane & 31)] = tv[i]; }
    LDS_WAIT(); asm volatile("" ::: "memory");
    const int c = lane & 7;
#pragma unroll
    for (int j = 0; j < 4; ++j) { const int n = (lane >> 3) + 8 * j; const LAS float* s = scr + (8 * c) * 33 + n;
        u32x4 o; o.x = pk2(s[0 * 33], s[1 * 33]); o.y = pk2(s[2 * 33], s[3 * 33]); o.z = pk2(s[4 * 33], s[5 * 33]); o.w = pk2(s[6 * 33], s[7 * 33]);
        *(u32x4*)(WT + (size_t)(dst_n0 + n) * K + k0 + 8 * c) = o; }
    LDS_WAIT(); asm volatile("" ::: "memory");
}
__device__ __forceinline__ void convert_weights(const Ptrs& A, int l, LAS unsigned char* lds, int gw, int NGW, int wave, int lane_) {
    const int lane = opaque(lane_);
    LAS float* scr = (LAS float*)(lds + wave * 16384);
    unsigned char* ws = A.ws();
    constexpr int I_IN = 32 * 416, I_BR = 16 * 64, I_O = 32 * 64, I_GU = 32 * 352, I_DN = 88 * 64, I_MK = 32 * 64;
    const int total = I_IN + 3 * I_BR + I_O + I_GU + I_DN + (l == 0 ? 2 * I_MK : 0);
    for (int it = gw; it < total; it += NGW) {
        int r = it;
        if (r < I_IN) { const int kb = r / 416, nb = r % 416, dn = 32 * nb; transpose_item(A.in(3) + (size_t)l * DM * INW, INW, dn + (dn >= 3072 ? 16 : 0), 64 * kb, (bf16*)(ws + WS_WIN), DM, dn, scr, lane); continue; } r -= I_IN;
        if (r < 3 * I_BR) { const int br = r / I_BR, q = r % I_BR, kb = q / 64, nb = q % 64; const float* W = (br == 0 ? A.in(7) : (br == 1 ? A.in(10) : A.in(15))) + (size_t)l * 1024 * DM;
            transpose_item(W, DM, 32 * nb, 64 * kb, (bf16*)(ws + WS_WBR), 1024, br * 2048 + 32 * nb, scr, lane); continue; } r -= 3 * I_BR;
        if (r < I_O) { const int kb = r / 64, nb = r % 64; transpose_item(A.in(16) + (size_t)l * DM * DM, DM, 32 * nb, 64 * kb, (bf16*)(ws + WS_WO), DM, 32 * nb, scr, lane); continue; } r -= I_O;
        if (r < I_GU) { const int kb = r / 352, nb = r % 352, dn = 32 * nb, p = dn >> 8, half = (dn >> 7) & 1, q = dn & 127;
            transpose_item(A.in(18) + (size_t)l * DM * 2 * DFF, 2 * DFF, half * DFF + 128 * p + q, 64 * kb, (bf16*)(ws + WS_WGU), DM, dn, scr, lane); continue; } r -= I_GU;
        if (r < I_DN) { const int kb = r / 64, nb = r % 64; transpose_item(A.in(19) + (size_t)l * DFF * DM, DM, 32 * nb, 64 * kb, (bf16*)(ws + WS_WDN), DFF, 32 * nb, scr, lane); continue; } r -= I_DN;
        { const int l2 = r / I_MK, q = r % I_MK, kb = q / 64, nb = q % 64; transpose_item(A.in(12) + (size_t)l2 * DM * DM, DM, 32 * nb, 64 * kb, (bf16*)(ws + WS_WMK) + (size_t)l2 * DM * DM, DM, 32 * nb, scr, lane); }
    }
}
template <bool GA, bool XBF = false>
__device__ __forceinline__ void norm_rows(const float* X, const float* gain, bf16* H, float* GA1, const LAS float* waT, int nrows, int gw, int NGW, int lane_) {
    const int lane = opaque(lane_);
    for (int m = gw; m < nrows; m += NGW) {
        f32x4 v[8]; float s = 0.f;
        if constexpr (XBF) { const u32x2* xb = (const u32x2*)((const bf16*)X + (size_t)m * DM) + lane;
#pragma unroll
            for (int j = 0; j < 8; ++j) { const u32x2 w = xb[64 * j]; v[j] = (f32x4){bflo(w.x), bfhi(w.x), bflo(w.y), bfhi(w.y)}; }
        } else { const f32x4* xr = (const f32x4*)(X + (size_t)m * DM) + lane;
#pragma unroll
            for (int j = 0; j < 8; ++j) v[j] = __builtin_nontemporal_load(xr + 64 * j); }
#pragma unroll
        for (int j = 0; j < 8; ++j) s += (v[j].x * v[j].x + v[j].y * v[j].y) + (v[j].z * v[j].z + v[j].w * v[j].w);
        const float rinv = 1.0f / sqrtf(wave_sum(s) * (1.0f / DM) + EPS);
        unsigned long long* o8 = (unsigned long long*)(H + (size_t)m * DM) + lane;
#pragma unroll
        for (int j = 0; j < 8; ++j) { const f32x4 g = ((const f32x4*)gain)[lane + 64 * j]; v[j] = v[j] * rinv * g;
            o8[64 * j] = (unsigned long long)pk2(v[j].x, v[j].y) | ((unsigned long long)pk2(v[j].z, v[j].w) << 32); }
        if constexpr (GA) {
            float mine = 0.f;
#pragma unroll 1
            for (int r = 0; r < 16; ++r) { float a = 0.f;
#pragma unroll
                for (int j = 0; j < 8; ++j) { const f32x4 w = *(const LAS f32x4*)(waT + r * DM + 256 * j + 4 * lane); a += (v[j].x * w.x + v[j].y * w.y) + (v[j].z * w.z + v[j].w * w.w); }
                a = wave_sum(a); mine = (lane == r) ? a : mine; }
            if (lane < 16) GA1[(size_t)m * 16 + lane] = mine;
        }
    }
}
__device__ __forceinline__ void qknorm_one(const u32x4 w0, const u32x4 w1, bf16* base, const float* gain, const int which, const float fac) {
    float x[16];
    x[0] = bflo(w0.x); x[1] = bfhi(w0.x); x[2] = bflo(w0.y); x[3] = bfhi(w0.y); x[4] = bflo(w0.z); x[5] = bfhi(w0.z); x[6] = bflo(w0.w); x[7] = bfhi(w0.w);
    x[8] = bflo(w1.x); x[9] = bfhi(w1.x); x[10] = bflo(w1.y); x[11] = bfhi(w1.y); x[12] = bflo(w1.z); x[13] = bfhi(w1.z); x[14] = bflo(w1.w); x[15] = bfhi(w1.w);
    float s = 0.f;
#pragma unroll
    for (int e = 0; e < 16; ++e) s += x[e] * x[e];
    s = (which == 2) ? red16(s) : red8(s);
    const float rinv = fac / sqrtf(s * (which == 2 ? (1.0f / 256.0f) : (1.0f / 128.0f)) + EPS);
#pragma unroll
    for (int e = 0; e < 16; ++e) x[e] = x[e] * rinv * gain[e];
    u32x4 o0, o1; o0.x = pk2(x[0], x[1]); o0.y = pk2(x[2], x[3]); o0.z = pk2(x[4], x[5]); o0.w = pk2(x[6], x[7]);
    o1.x = pk2(x[8], x[9]); o1.y = pk2(x[10], x[11]); o1.z = pk2(x[12], x[13]); o1.w = pk2(x[14], x[15]);
    *(u32x4*)base = o0; *(u32x4*)(base + 8) = o1;
}
__device__ __forceinline__ void qknorm_rows(const Ptrs& A, int l, int gw, int NGW, int lane_) {
    const int lane = opaque(lane_);
    unsigned char* ws = A.ws();
    for (int id = gw; id < 3 * T; id += 2 * NGW) {
        const int which = id / T, row = id - which * T; const int id2 = id + NGW; const bool two = (id2 < 3 * T) && (id2 / T == which);
        bf16* base = (bf16*)(ws + (which == 0 ? WS_SQ : (which == 1 ? WS_SK : WS_MQ))) + (size_t)row * 1024 + 16 * lane;
        bf16* base2 = base + (size_t)NGW * 1024;
        const int hw = (which == 2) ? 16 : 8;
        const float* gain = (which == 0 ? A.in(8) : (which == 1 ? A.in(9) : A.in(13))) + (size_t)l * (which == 2 ? 256 : 128) + 16 * (lane & (hw - 1));
        const float fac = (which == 0) ? (0.08838834764831845f * LOG2E) : ((which == 2) ? (0.0625f * LOG2E) : 1.0f);
        const u32x4 w0 = *(const u32x4*)base, w1 = *(const u32x4*)(base + 8);
        u32x4 v0 = w0, v1 = w1;
        if (two) { v0 = *(const u32x4*)base2; v1 = *(const u32x4*)(base2 + 8); }
        qknorm_one(w0, w1, base, gain, which, fac);
        if (two) qknorm_one(v0, v1, base2, gain, which, fac);
        else if (id2 < 3 * T) {
            const int which2 = id2 / T, row2 = id2 - which2 * T;
            bf16* b2 = (bf16*)(ws + (which2 == 0 ? WS_SQ : (which2 == 1 ? WS_SK : WS_MQ))) + (size_t)row2 * 1024 + 16 * lane;
            const int hw2 = (which2 == 2) ? 16 : 8;
            const float* gain2 = (which2 == 0 ? A.in(8) : (which2 == 1 ? A.in(9) : A.in(13))) + (size_t)l * (which2 == 2 ? 256 : 128) + 16 * (lane & (hw2 - 1));
            const float fac2 = (which2 == 0) ? (0.08838834764831845f * LOG2E) : ((which2 == 2) ? (0.0625f * LOG2E) : 1.0f);
            const u32x4 y0 = *(const u32x4*)b2, y1 = *(const u32x4*)(b2 + 8);
            qknorm_one(y0, y1, b2, gain2, which2, fac2);
        }
    }
}
__device__ __forceinline__ void memkv_naive(const Ptrs& A, LAS unsigned char* lds, int wave, int lane_, const int wv0) {
    unsigned char* ws = A.ws(); const int tid = opaque(TID()), lane = tid & 63, r32 = lane & 31, hi = lane >> 5;
    LAS float* red = (LAS float*)lds;
    for (int id = blockIdx.x; id < 1024; id += gridDim.x) {
        const int l2 = id >> 9, rem = id & 511, mt = rem >> 6, nt = rem & 63;
        const bf16* hm = (const bf16*)(ws + WS_HM) + ((size_t)l2 * 256 + 32 * mt + r32) * DM + 256 * wave + 8 * hi;
        const bf16* wk = (const bf16*)(ws + WS_WMK) + ((size_t)l2 * DM + 32 * nt + r32) * DM + 256 * wave + 8 * hi;
        f32x16 acc = {};
#pragma unroll 4
        for (int s = 0; s < 16; ++s) { const bf16x8 a = *(const bf16x8*)(hm + 16 * s), b = *(const bf16x8*)(wk + 16 * s); acc = __builtin_amdgcn_mfma_f32_32x32x16_bf16(a, b, acc, 0, 0, 0); }
#pragma unroll
        for (int r = 0; r < 16; ++r) red[(wave * 16 + r) * 64 + lane] = acc[r];
        __syncthreads();
#pragma unroll
        for (int i = 0; i < 2; ++i) { const int e = tid + 512 * i, r = e >> 6, ln = e & 63; float s = 0.f;
#pragma unroll
            for (int w = 0; w < 8; ++w) s += red[(w * 16 + r) * 64 + ln];
            ((float*)(ws + WS_MEMKV))[((size_t)l2 * 256 + 32 * mt + crow(r, ln >> 5)) * DM + 32 * nt + (ln & 31)] = s; }
        __syncthreads();
    }
}
__device__ __forceinline__ void memkv_post(const Ptrs& A, int gw, int NGW, int lane_) {
    const int lane = opaque(lane_);
    unsigned char* ws = A.ws(); const float* kv = (const float*)(ws + WS_MEMKV);
    for (int id = gw; id < 2048; id += NGW) {
        const int l2 = id >> 10, hd = (id >> 8) & 3, m = id & 255;
        const f32x4 x = *(const f32x4*)(kv + ((size_t)l2 * 256 + m) * DM + hd * 256 + 4 * lane);
        const float s = wave_sum((x.x * x.x + x.y * x.y) + (x.z * x.z + x.w * x.w));
        const float rinv = 1.0f / sqrtf(s * (1.0f / 256.0f) + EPS);
        const f32x4 g = *(const f32x4*)(A.in(14) + (size_t)l2 * 256 + 4 * lane);
        *(unsigned long long*)((bf16*)(ws + WS_KN) + (((size_t)l2 * 4 + hd) * 256 + m) * 256 + 4 * lane) =
            (unsigned long long)pk2(x.x * rinv * g.x, x.y * rinv * g.y) | ((unsigned long long)pk2(x.z * rinv * g.z, x.w * rinv * g.w) << 32);
    }
    const int gt = gw * 64 + lane, NGT = NGW * 64;
    for (int id = gt; id < 65536; id += NGT) {
        const int l2 = id >> 15, row = (id >> 5) & 1023, mg = id & 31;
        const float* src = kv + ((size_t)l2 * 256 + 8 * mg) * DM + 1024 + row;
        u32x4 o; o.x = pk2(src[0], src[DM]); o.y = pk2(src[2 * DM], src[3 * DM]); o.z = pk2(src[4 * DM], src[5 * DM]); o.w = pk2(src[6 * DM], src[7 * DM]);
        *(u32x4*)((bf16*)(ws + WS_VT) + ((size_t)l2 * 1024 + row) * 256 + 8 * mg) = o;
    }
}
constexpr int BLS = 132;
__device__ __forceinline__ void gla_cumdecay(const Ptrs& A, int l, int n, int hd, LAS float* bl, const int wv0) {
    const int tid = opaque(TID()), d = tid & 127, tq = __builtin_amdgcn_readfirstlane(tid >> 7);
    const float* wa2 = A.in(4) + (size_t)l * 16 * 512 + hd * 128 + d;
    float w[16];
#pragma unroll
    for (int r = 0; r < 16; ++r) w[r] = wa2[r * 512];
    const float bias = A.in(5)[(size_t)l * 512 + hd * 128 + d];
    LAS float* gal = bl + 29184;
    *(LAS f32x2*)(gal + 2 * tid) = *(const f32x2*)((const float*)(A.ws() + WS_GA1) + (size_t)n * 64 * 16 + 2 * tid);
    __syncthreads();
    const LAS float* ga = gal + 16 * tq * 16;
    float run = 0.f;
    for (int tt = 0; tt < 16; ++tt) {
        float pre = bias;
        const f32x4 g0 = *(const LAS f32x4*)(ga + tt * 16), g1 = *(const LAS f32x4*)(ga + tt * 16 + 4), g2 = *(const LAS f32x4*)(ga + tt * 16 + 8), g3 = *(const LAS f32x4*)(ga + tt * 16 + 12);
        pre += (g0.x * w[0] + g0.y * w[1]) + (g0.z * w[2] + g0.w * w[3]); pre += (g1.x * w[4] + g1.y * w[5]) + (g1.z * w[6] + g1.w * w[7]);
        pre += (g2.x * w[8] + g2.y * w[9]) + (g2.z * w[10] + g2.w * w[11]); pre += (g3.x * w[12] + g3.y * w[13]) + (g3.z * w[14] + g3.w * w[15]);
        const float la = (fminf(pre, 0.f) - __logf(1.0f + __expf(-fabsf(pre)))) * (1.0f / 16.0f);
        run += la; bl[(16 * tq + tt) * BLS + d] = run;
    }
    __syncthreads();
    float add = 0.f;
#pragma unroll
    for (int q = 0; q < 3; ++q) if (q < tq) add += bl[(16 * q + 15) * BLS + d];
    __syncthreads();
    if (tq > 0) for (int tt = 0; tt < 16; ++tt) bl[(16 * tq + tt) * BLS + d] += add;
    __syncthreads();
}
__device__ __forceinline__ void unpack8(const u32x4 w, float* x) { x[0] = bflo(w.x); x[1] = bfhi(w.x); x[2] = bflo(w.y); x[3] = bfhi(w.y); x[4] = bflo(w.z); x[5] = bfhi(w.z); x[6] = bflo(w.w); x[7] = bfhi(w.w); }
__device__ __forceinline__ void gla_load_vt(const bf16* GVc, LAS bf16* VTl, int wave, int lane) {
    u32x4 vv[4];
#pragma unroll
    for (int i = 0; i < 4; ++i) vv[i] = *(const u32x4*)(GVc + (size_t)lane * 1024 + (wave + 8 * i) * 8);
#pragma unroll
    for (int i = 0; i < 4; ++i) { const int v0 = (wave + 8 * i) * 8; LAS bf16* p = VTl + v0 * 72 + lane;
        p[0] = (bf16)(vv[i].x & 0xffff); p[72] = (bf16)(vv[i].x >> 16); p[144] = (bf16)(vv[i].y & 0xffff); p[216] = (bf16)(vv[i].y >> 16);
        p[288] = (bf16)(vv[i].z & 0xffff); p[360] = (bf16)(vv[i].z >> 16); p[432] = (bf16)(vv[i].w & 0xffff); p[504] = (bf16)(vv[i].w >> 16); }
}
__device__ __forceinline__ void gla_state(const Ptrs& A, int l, LAS unsigned char* lds, int c, int G, int wave, int lane_, const int wv0) {
    unsigned char* ws = A.ws(); const int tid = opaque(TID()), lane = tid & 63, r32 = lane & 31, hi = lane >> 5;
    LAS float* bl = (LAS float*)lds; LAS bf16* KdT = (LAS bf16*)(lds + 33792); LAS bf16* VTl = (LAS bf16*)(lds + 33792 + 128 * 72 * 2);
    const bf16* GK = (const bf16*)(ws + WS_GK); const bf16* GV = (const bf16*)(ws + WS_GV); bf16* US = (bf16*)(ws + WS_H);
    for (int it = c; it < 1024; it += G) {
        const int n = it >> 2, hd = it & 3, t0 = n * 64;
        u32x4 kk[2];
#pragma unroll
        for (int i = 0; i < 2; ++i) kk[i] = *(const u32x4*)(GK + (size_t)(t0 + lane) * 512 + hd * 128 + (wave + 8 * i) * 8);
        gla_cumdecay(A, l, n, hd, bl, wv0);
        gla_load_vt(GV + (size_t)t0 * 1024 + hd * 256, VTl, wave, lane);
#pragma unroll
        for (int i = 0; i < 2; ++i) { const int d0 = (wave + 8 * i) * 8; float x[8]; unpack8(kk[i], x);
            const f32x4 b0 = *(const LAS f32x4*)(bl + lane * BLS + d0), b1 = *(const LAS f32x4*)(bl + lane * BLS + d0 + 4);
            const f32x4 e0 = *(const LAS f32x4*)(bl + 63 * BLS + d0), e1 = *(const LAS f32x4*)(bl + 63 * BLS + d0 + 4);
            LAS bf16* p = KdT + d0 * 72 + lane;
            p[0] = (bf16)f2bf(x[0] * __expf(e0.x - b0.x)); p[72] = (bf16)f2bf(x[1] * __expf(e0.y - b0.y)); p[144] = (bf16)f2bf(x[2] * __expf(e0.z - b0.z)); p[216] = (bf16)f2bf(x[3] * __expf(e0.w - b0.w));
            p[288] = (bf16)f2bf(x[4] * __expf(e1.x - b1.x)); p[360] = (bf16)f2bf(x[5] * __expf(e1.y - b1.y)); p[432] = (bf16)f2bf(x[6] * __expf(e1.z - b1.z)); p[504] = (bf16)f2bf(x[7] * __expf(e1.w - b1.w)); }
        if (tid < 128) ((float*)(ws + WS_DEC))[(size_t)it * 128 + tid] = __expf(bl[63 * BLS + tid]);
        __syncthreads();
        bf16x8 af[4];
#pragma unroll
        for (int ks = 0; ks < 4; ++ks) af[ks] = *(const LAS bf16x8*)(VTl + (32 * wave + r32) * 72 + 16 * ks + 8 * hi);
#pragma unroll
        for (int j = 0; j < 4; ++j) { f32x16 acc = {};
#pragma unroll
            for (int ks = 0; ks < 4; ++ks) { const bf16x8 b = *(const LAS bf16x8*)(KdT + (32 * j + r32) * 72 + 16 * ks + 8 * hi); acc = __builtin_amdgcn_mfma_f32_32x32x16_bf16(af[ks], b, acc, 0, 0, 0); }
#pragma unroll
            for (int r = 0; r < 16; ++r) US[((size_t)it * 256 + 32 * wave + crow(r, hi)) * 128 + 32 * j + r32] = (bf16)f2bf(acc[r]); }
        __syncthreads();
    }
}
__device__ __forceinline__ void gla_scan(const Ptrs& A, const int wv0) {
    const int tid = opaque(TID());
    unsigned char* ws = A.ws();
    for (int g = blockIdx.x * 512 + tid; g < 131072; g += gridDim.x * 512) {
        const int hd = g >> 15, v = (g >> 7) & 255, d = g & 127;
        bf16* us = (bf16*)(ws + WS_H) + ((size_t)hd * 256 + v) * 128 + d;
        const float* dec = (const float*)(ws + WS_DEC) + hd * 128 + d;
        float st = 0.f;
        for (int n0 = 0; n0 < 256; n0 += 64) {
            bf16 u[64]; float dc[64];
#pragma unroll
            for (int i = 0; i < 64; ++i) { u[i] = us[(size_t)(n0 + i) * 131072]; dc[i] = dec[(size_t)(n0 + i) * 512]; }
#pragma unroll
            for (int i = 0; i < 64; ++i) { us[(size_t)(n0 + i) * 131072] = (bf16)f2bf(st); st = st * dc[i] + bf2f(u[i]); }
        }
    }
}
__device__ __forceinline__ void gla_out(const Ptrs& A, int l, LAS unsigned char* lds, int c, int G, int wave, int lane_, const int wv0) {
    unsigned char* ws = A.ws(); const int tid = opaque(TID()), lane = tid & 63, r32 = lane & 31, hi = lane >> 5;
    LAS float* bl = (LAS float*)lds; LAS bf16* QE = (LAS bf16*)(lds + 33792); LAS bf16* KE = (LAS bf16*)(lds + 51200); LAS bf16* VTl = (LAS bf16*)(lds + 68608);
    LAS bf16* SM = (LAS bf16*)(lds + 105472); LAS float* red = (LAS float*)(lds + 114688);
    const bf16* GQ = (const bf16*)(ws + WS_GQ); const bf16* GK = (const bf16*)(ws + WS_GK); const bf16* GV = (const bf16*)(ws + WS_GV); const bf16* GR = (const bf16*)(ws + WS_GR);
    const bf16* US = (const bf16*)(ws + WS_H); bf16* AG = (bf16*)(ws + WS_ABR);
    const float* gout = A.in(6) + (size_t)l * 256;
    for (int it = c; it < 1024; it += G) {
        const int n = it >> 2, hd = it & 3, t0 = n * 64;
        u32x4 qq[2], kk[2];
#pragma unroll
        for (int i = 0; i < 2; ++i) { qq[i] = *(const u32x4*)(GQ + (size_t)(t0 + lane) * 512 + hd * 128 + (wave + 8 * i) * 8); kk[i] = *(const u32x4*)(GK + (size_t)(t0 + lane) * 512 + hd * 128 + (wave + 8 * i) * 8); }
        gla_cumdecay(A, l, n, hd, bl, wv0);
        gla_load_vt(GV + (size_t)t0 * 1024 + hd * 256, VTl, wave, lane);
#pragma unroll
        for (int i = 0; i < 2; ++i) { const int d0 = (wave + 8 * i) * 8; float xq[8], xk[8]; unpack8(qq[i], xq); unpack8(kk[i], xk);
            const f32x4 b0 = *(const LAS f32x4*)(bl + lane * BLS + d0), b1 = *(const LAS f32x4*)(bl + lane * BLS + d0 + 4);
            float eb[8]; eb[0] = __expf(b0.x); eb[1] = __expf(b0.y); eb[2] = __expf(b0.z); eb[3] = __expf(b0.w); eb[4] = __expf(b1.x); eb[5] = __expf(b1.y); eb[6] = __expf(b1.z); eb[7] = __expf(b1.w);
            u32x4 oq, ok;
            oq.x = pk2(xq[0] * 0.08838834764831845f * eb[0], xq[1] * 0.08838834764831845f * eb[1]); oq.y = pk2(xq[2] * 0.08838834764831845f * eb[2], xq[3] * 0.08838834764831845f * eb[3]);
            oq.z = pk2(xq[4] * 0.08838834764831845f * eb[4], xq[5] * 0.08838834764831845f * eb[5]); oq.w = pk2(xq[6] * 0.08838834764831845f * eb[6], xq[7] * 0.08838834764831845f * eb[7]);
            ok.x = pk2(xk[0] * __builtin_amdgcn_rcpf(eb[0]), xk[1] * __builtin_amdgcn_rcpf(eb[1])); ok.y = pk2(xk[2] * __builtin_amdgcn_rcpf(eb[2]), xk[3] * __builtin_amdgcn_rcpf(eb[3]));
            ok.z = pk2(xk[4] * __builtin_amdgcn_rcpf(eb[4]), xk[5] * __builtin_amdgcn_rcpf(eb[5])); ok.w = pk2(xk[6] * __builtin_amdgcn_rcpf(eb[6]), xk[7] * __builtin_amdgcn_rcpf(eb[7]));
            *(LAS u32x4*)(QE + lane * 136 + d0) = oq; *(LAS u32x4*)(KE + lane * 136 + d0) = ok; }
        __syncthreads();
        if (wave < 4) { const int ti = wave >> 1, tj = wave & 1; f32x16 acc = {};
            if (tj <= ti) {
#pragma unroll
                for (int ks = 0; ks < 8; ++ks) { const bf16x8 a = *(const LAS bf16x8*)(QE + (32 * ti + r32) * 136 + 16 * ks + 8 * hi), b = *(const LAS bf16x8*)(KE + (32 * tj + r32) * 136 + 16 * ks + 8 * hi);
                    acc = __builtin_amdgcn_mfma_f32_32x32x16_bf16(a, b, acc, 0, 0, 0); } }
#pragma unroll
            for (int r = 0; r < 16; ++r) { const int t = 32 * ti + crow(r, hi), sx = 32 * tj + r32; SM[t * 72 + sx] = (bf16)f2bf(sx <= t ? acc[r] : 0.f); } }
        __syncthreads();
        const int ti = wave & 1, vq = wave >> 1;
        f32x16 o0 = {}, o1 = {};
        {
            const bf16* sb0 = US + ((size_t)it * 256 + 64 * vq + r32) * 128 + 8 * hi; const bf16* sb1 = sb0 + 32 * 128;
#pragma unroll
            for (int ks = 0; ks < 8; ++ks) { const bf16x8 a = *(const LAS bf16x8*)(QE + (32 * ti + r32) * 136 + 16 * ks + 8 * hi);
                const bf16x8 b0 = *(const bf16x8*)(sb0 + 16 * ks), b1 = *(const bf16x8*)(sb1 + 16 * ks);
                o0 = __builtin_amdgcn_mfma_f32_32x32x16_bf16(a, b0, o0, 0, 0, 0); o1 = __builtin_amdgcn_mfma_f32_32x32x16_bf16(a, b1, o1, 0, 0, 0); }
#pragma unroll
            for (int ks = 0; ks < 4; ++ks) { const bf16x8 a = *(const LAS bf16x8*)(SM + (32 * ti + r32) * 72 + 16 * ks + 8 * hi);
                const bf16x8 b0 = *(const LAS bf16x8*)(VTl + (64 * vq + r32) * 72 + 16 * ks + 8 * hi), b1 = *(const LAS bf16x8*)(VTl + (64 * vq + 32 + r32) * 72 + 16 * ks + 8 * hi);
                o0 = __builtin_amdgcn_mfma_f32_32x32x16_bf16(a, b0, o0, 0, 0, 0); o1 = __builtin_amdgcn_mfma_f32_32x32x16_bf16(a, b1, o1, 0, 0, 0); }
        }
#pragma unroll
        for (int r = 0; r < 16; ++r) { float p = o0[r] * o0[r] + o1[r] * o1[r];
            p = red32(p);
            if (r32 == 0) red[vq * 64 + 32 * ti + crow(r, hi)] = p; }
        __syncthreads();
        const float g0 = gout[64 * vq + r32], g1 = gout[64 * vq + 32 + r32];
#pragma unroll
        for (int r = 0; r < 16; ++r) { const int t = 32 * ti + crow(r, hi);
            const float tot = (red[t] + red[64 + t]) + (red[128 + t] + red[192 + t]); const float rinv = 1.0f / sqrtf(tot * (1.0f / 256.0f) + EPS);
            const size_t off = (size_t)(t0 + t) * 1024 + hd * 256 + 64 * vq + r32;
            const float r0 = bf2f(GR[off]), r1 = bf2f(GR[off + 32]);
            AG[off] = (bf16)f2bf(o0[r] * rinv * g0 * r0 * pg8::sigmoid_f(r0)); AG[off + 32] = (bf16)f2bf(o1[r] * rinv * g1 * r1 * pg8::sigmoid_f(r1)); }
        __syncthreads();
    }
}

#ifndef PHASE_MASK
#define PHASE_MASK 0x7ff
#endif
#define PH(k) (((PHASE_MASK) >> (k)) & 1)
#ifndef DUP_GEMM
#define DUP_GEMM 0
#endif
#ifndef DUP_SYNC
#define DUP_SYNC 0
#endif
#ifndef DUP_ATTN
#define DUP_ATTN 0
#endif
#ifndef DUP_P5
#define DUP_P5 0
#endif
#define GBAR() do { XcdBarrier xb_; xb_.bar = (unsigned*)(A.ws() + WS_CTL); xb_.x = xb_xcc_id(); { unsigned a_; asm volatile("v_mov_b32 %0, %1" : "=v"(a_) : "s"(A.base + 192u)); xb_.st = (volatile LAS unsigned*)a_; } xcd_barrier(xb_, wv0); } while (0)
template <int l>
__device__ __forceinline__ void layer_body(const Ptrs& A, LAS unsigned char* lds, unsigned char* lds_raw, const int wv0) {
    unsigned char* ws; int tid, lane, wave, G, c, gw, NGW;
#define FRESH() do { ws = opaque_p(A.ws()); tid = opaque(TID()); lane = tid & 63; wave = __builtin_amdgcn_readfirstlane(tid >> 6); G = opaque_s(gridDim.x); c = opaque_s(blockIdx.x); gw = c * 8 + wave; NGW = G * 8; } while (0)


        FRESH();
        if (PH(1)) {
            convert_weights(A, l, lds, gw, NGW, wave, lane);
            __syncthreads();
            LAS float* waT = (LAS float*)lds;
            const float* win = A.in(3) + (size_t)l * DM * INW + 3072;
            for (int idx = tid; idx < 16 * DM; idx += 512) { const int k = idx >> 4, r = idx & 15; waT[r * DM + k] = win[(size_t)k * INW + r]; }
            __syncthreads();
            if constexpr (l == 0) norm_rows<true, false>(A.in(0), A.in(2) + (size_t)l * DM, (bf16*)(ws + WS_H), (float*)(ws + WS_GA1), waT, T, gw, NGW, lane);
            else norm_rows<true, true>((const float*)(ws + WS_X), A.in(2) + (size_t)l * DM, (bf16*)(ws + WS_H), (float*)(ws + WS_GA1), waT, T, gw, NGW, lane);
            if (l == 0) {
                norm_rows<false>(A.in(1), A.in(11), (bf16*)(ws + WS_HM), nullptr, waT, NMEM, gw, NGW, lane);
                norm_rows<false>(A.in(1), A.in(11) + DM, (bf16*)(ws + WS_HM) + (size_t)NMEM * DM, nullptr, waT, NMEM, gw, NGW, lane);
            }
            __syncthreads();
        }
        if constexpr (l == 0) cg::this_grid().sync(); else GBAR();
        if (DUP_SYNC) { GBAR(); GBAR(); }
        FRESH();
        if (PH(2)) {
            pg8::Gemm g{DM, DM, DM}; pg8::SchedGrid S; S.to.init(T / 256, NP / 256); S.G = G; S.c = c; S.A = (const char*)(ws + WS_H); S.B = (const char*)(ws + WS_WIN); S.ta = (size_t)256 * DM * 2; S.tb = (size_t)256 * DM * 2;
            pg8::EpiProj E{ws};
#pragma unroll 1
            for (int rep = 0; rep < 1 + DUP_GEMM; ++rep) { pg8::gemm_phase<pg8::EpiProj, pg8::SchedGrid, true, true>(lds, g, S, E, wv0); __syncthreads(); }
        }
        GBAR();
        if (DUP_SYNC) { GBAR(); GBAR(); }
        FRESH();
        if (PH(3)) {
            if (l == 0) memkv_naive(A, lds, wave, lane, wv0);
            qknorm_rows(A, l, gw, NGW, lane);
            __syncthreads();
            gla_state(A, l, lds, c, G, wave, lane, wv0);
        }
        GBAR();
        if (DUP_SYNC) { GBAR(); GBAR(); }
        FRESH();
        if (PH(4)) {
            if (l == 0) memkv_post(A, gw, NGW, lane);
            for (int u = c; u < 256 * (1 + DUP_ATTN); u += G) {
                const int head = (u & 255) >> 5, p = u & 31;
                const bf16* Q = (const bf16*)(ws + WS_SQ) + head * 128; const bf16* Kp = (const bf16*)(ws + WS_SK) + head * 128; const bf16* V = (const bf16*)(ws + WS_SV) + head * 128;
                bf16* O = (bf16*)(ws + WS_ABR) + (size_t)T * 1024 + head * 128;
#pragma unroll 1
                for (int rep = 0; rep < 2; ++rep) sba::sb_unit(Q, Kp, V, O, (rep ? p : 63 - p) * 256, (char*)lds_raw, wv0);
            }
            __syncthreads();
            gla_scan(A, wv0);
        }
        GBAR();
        if (DUP_SYNC) { GBAR(); GBAR(); }
        FRESH();
        if (PH(5)) {
#ifndef NO_MEMATT
            for (int u = c; u < 256; u += G) {
                const int pm = u >> 2, hd = u & 3;
                { pg8::Gemm g{256, 1024, 256}; pg8::SchedOne S; S.one.pm = pm; S.one.pn = hd; S.one.aux = 0;
                  S.one.a = (const char*)((const bf16*)(ws + WS_MQ) + (size_t)pm * 256 * 1024 + hd * 256); S.one.b = (const char*)((const bf16*)(ws + WS_KN) + ((size_t)l * 4 + hd) * 256 * 256);
                  pg8::EpiSoftmax E{(bf16*)(ws + WS_SQ)};
                  pg8::gemm_phase<pg8::EpiSoftmax, pg8::SchedOne, false, true>(lds, g, S, E, wv0); }
                asm volatile("s_waitcnt vmcnt(0)" ::: "memory"); __syncthreads();
                { pg8::Gemm g{256, 1024, 256}; pg8::SchedOne S; S.one.pm = pm; S.one.pn = hd; S.one.aux = 0;
                  S.one.a = (const char*)((const bf16*)(ws + WS_SQ) + (size_t)pm * 256 * 1024 + hd * 256); S.one.b = (const char*)((const bf16*)(ws + WS_VT) + ((size_t)l * 1024 + hd * 256) * 256);
                  pg8::EpiBf16 E{(bf16*)(ws + WS_ABR) + (size_t)2 * T * 1024, 1024};
                  pg8::gemm_phase<pg8::EpiBf16, pg8::SchedOne, false, true>(lds, g, S, E, wv0); }
                __syncthreads();
            }
#endif
#ifndef NO_GLAOUT
            gla_out(A, l, lds, c, G, wave, lane, wv0);
#endif
        }
        GBAR();
        if (DUP_SYNC) { GBAR(); GBAR(); }
        FRESH();
        if (PH(6)) {
            pg8::Gemm g{1024, 1024, 1024}; pg8::SchedBranch S; S.to.init(T / 256, DM / 256); S.G = G; S.c = c; S.A = (const char*)(ws + WS_ABR); S.B = (const char*)(ws + WS_WBR);
            pg8::EpiMerge E{(const unsigned char*)(ws + WS_GATES), (bf16*)(ws + WS_GV)};
#pragma unroll 1
            for (int rep = 0; rep < 1 + DUP_GEMM; ++rep) { pg8::gemm_phase<pg8::EpiMerge, pg8::SchedBranch, true, true>(lds, g, S, E, wv0); __syncthreads(); }
        }
        GBAR();
        if (DUP_SYNC) { GBAR(); GBAR(); }
        FRESH();
        if (PH(7)) {
            pg8::Gemm g{DM, DM, DM}; pg8::SchedGrid S; S.to.init(T / 256, DM / 256); S.G = G; S.c = c; S.A = (const char*)(ws + WS_GV); S.B = (const char*)(ws + WS_WO); S.ta = (size_t)256 * DM * 2; S.tb = (size_t)256 * DM * 2;
            if constexpr (l == 0) { pg8::EpiRes<false, true> E{(const void*)A.in(0), (void*)(ws + WS_X)}; pg8::gemm_phase<pg8::EpiRes<false, true>, pg8::SchedGrid, true, true>(lds, g, S, E, wv0); }
            else { pg8::EpiRes<true, true> E{(const void*)(ws + WS_X), (void*)(ws + WS_X)}; pg8::gemm_phase<pg8::EpiRes<true, true>, pg8::SchedGrid, true, true>(lds, g, S, E, wv0); }
        }
        GBAR();
        if (DUP_SYNC) { GBAR(); GBAR(); }
        FRESH();
        if (PH(8)) norm_rows<false, true>((const float*)(ws + WS_X), A.in(17) + (size_t)l * DM, (bf16*)(ws + WS_H), nullptr, (const LAS float*)lds, T, gw, NGW, lane);
        GBAR();
        if (DUP_SYNC) { GBAR(); GBAR(); }
        FRESH();
        if (PH(9)) {
            pg8::Gemm g{DM, DM, DM}; pg8::SchedGrid S; S.to.init(T / 256, 2 * DFF / 256); S.G = G; S.c = c; S.A = (const char*)(ws + WS_H); S.B = (const char*)(ws + WS_WGU); S.ta = (size_t)256 * DM * 2; S.tb = (size_t)256 * DM * 2;
            pg8::EpiSwiglu E{(bf16*)(ws + WS_GATES)};
#pragma unroll 1
            for (int rep = 0; rep < 1 + DUP_GEMM; ++rep) { pg8::gemm_phase<pg8::EpiSwiglu, pg8::SchedGrid, true, true>(lds, g, S, E, wv0); __syncthreads(); }
        }
        GBAR();
        if (DUP_SYNC) { GBAR(); GBAR(); }
        FRESH();
        if (PH(10)) {
            pg8::Gemm g{DFF, DFF, DFF}; pg8::SchedGrid S; S.to.init(T / 256, DM / 256); S.G = G; S.c = c; S.A = (const char*)(ws + WS_GATES); S.B = (const char*)(ws + WS_WDN); S.ta = (size_t)256 * DFF * 2; S.tb = (size_t)256 * DFF * 2;
            if constexpr (l + 1 < DEPTH) { pg8::EpiRes<true, true> E{(const void*)(ws + WS_X), (void*)(ws + WS_X)}; pg8::gemm_phase<pg8::EpiRes<true, true>, pg8::SchedGrid, true, true>(lds, g, S, E, wv0); }
            else { pg8::EpiRes<true, false> E{(const void*)(ws + WS_X), (void*)A.out()}; pg8::gemm_phase<pg8::EpiRes<true, false>, pg8::SchedGrid, true, true>(lds, g, S, E, wv0); }
        }
}

__global__ void __launch_bounds__(512, 2) fwd_megakernel(Args KA) {
    extern __shared__ __attribute__((aligned(16))) unsigned char lds_raw[];
    LAS unsigned char* lds = (LAS unsigned char*)lds_raw;
    const int wv0 = __builtin_amdgcn_readfirstlane(threadIdx.x >> 6);
    {
        LAS unsigned long long* tb = (LAS unsigned long long*)(lds + LDS_BYTES - 256);
        if (threadIdx.x == 0) {
            tb[0] = (unsigned long long)KA.in[0]; tb[1] = (unsigned long long)KA.in[1]; tb[2] = (unsigned long long)KA.in[2]; tb[3] = (unsigned long long)KA.in[3]; tb[4] = (unsigned long long)KA.in[4];
            tb[5] = (unsigned long long)KA.in[5]; tb[6] = (unsigned long long)KA.in[6]; tb[7] = (unsigned long long)KA.in[7]; tb[8] = (unsigned long long)KA.in[8]; tb[9] = (unsigned long long)KA.in[9];
            tb[10] = (unsigned long long)KA.in[10]; tb[11] = (unsigned long long)KA.in[11]; tb[12] = (unsigned long long)KA.in[12]; tb[13] = (unsigned long long)KA.in[13]; tb[14] = (unsigned long long)KA.in[14];
            tb[15] = (unsigned long long)KA.in[15]; tb[16] = (unsigned long long)KA.in[16]; tb[17] = (unsigned long long)KA.in[17]; tb[18] = (unsigned long long)KA.in[18]; tb[19] = (unsigned long long)KA.in[19];
            tb[20] = (unsigned long long)KA.out; tb[21] = (unsigned long long)KA.ws;
        }
        if (threadIdx.x < 2) ((LAS unsigned*)(lds + LDS_BYTES - 64))[threadIdx.x] = 0u;
        __syncthreads();
    }
    (void)xcd_barrier_post((unsigned*)(KA.ws + WS_CTL), (volatile LAS unsigned*)(lds + LDS_BYTES - 64), threadIdx.x == 0);
    Ptrs A; A.base = (unsigned)(size_t)(lds + LDS_BYTES - 256);
    layer_body<0>(A, lds, lds_raw, wv0);
    GBAR();
    layer_body<1>(A, lds, lds_raw, wv0);
}

extern "C" void kernel_launch(void* const* d_in, const int* in_sizes, int n_in, void* d_out, int out_size, void* d_ws, size_t ws_size, hipStream_t stream) {
    static int grid = 0;
    if (grid == 0) {
        if (n_in != 20 || in_sizes[0] != T * DM || out_size != T * DM || ws_size < WS_END) {
            fprintf(stderr, "kernel_launch: unexpected shapes (n_in %d, in0 %d, out %d, ws %zu need %zu)\n", n_in, n_in > 0 ? in_sizes[0] : -1, out_size, ws_size, (size_t)WS_END); grid = -1; return; }
        int dev = 0, cus = 0, per_cu = 0;
        (void)hipGetDevice(&dev); (void)hipDeviceGetAttribute(&cus, hipDeviceAttributeMultiprocessorCount, dev);
        if (hipFuncSetAttribute((const void*)fwd_megakernel, hipFuncAttributeMaxDynamicSharedMemorySize, LDS_BYTES) != hipSuccess) { fprintf(stderr, "kernel_launch: hipFuncSetAttribute failed\n"); grid = -1; return; }
        if (hipOccupancyMaxActiveBlocksPerMultiprocessor(&per_cu, (const void*)fwd_megakernel, 512, LDS_BYTES) != hipSuccess || per_cu < 1) { fprintf(stderr, "kernel_launch: occupancy query failed (%d)\n", per_cu); per_cu = 1; }
        (void)hipGetLastError();
        grid = cus * per_cu;
    }
    if (grid < 0) return;
    Args a{};
    for (int i = 0; i < 20; ++i) a.in[i] = (const float*)d_in[i];
    a.out = (float*)d_out; a.ws = (unsigned char*)d_ws;
    if (hipMemsetAsync((char*)d_ws + WS_CTL, 0, CTL_BYTES, stream) != hipSuccess) { fprintf(stderr, "kernel_launch: memset failed\n"); return; }
    void* args[] = {&a};
    hipError_t e = hipLaunchCooperativeKernel((const void*)fwd_megakernel, dim3(grid), dim3(512), args, LDS_BYTES, stream);
    if (e != hipSuccess) fprintf(stderr, "kernel_launch: cooperative launch failed: %s (grid %d)\n", hipGetErrorString(e), grid);
}
```
